# Optimizing an MI355X kernel written in HIP

```python
import jax, jax.numpy as jnp
from jax import lax
import numpy as np

D_MODEL = 1024
BATCH = 8
SEQ = 2048
DEPTH = 2

CHUNK = 64
D_MIX = D_MODEL
HEAD_DIM = 64
SB_HEADS = D_MIX // 2 // HEAD_DIM
SB_WIDTH = SB_HEADS * HEAD_DIM
SC_GROUPS = D_MIX // 4 // HEAD_DIM
SC_WIDTH = SC_GROUPS * HEAD_DIM
SG_HEADS = D_MIX // 4 // HEAD_DIM
SG_WIDTH = SG_HEADS * HEAD_DIM
SB_BLOCK = 128
SC_KERNEL = 3
SG_CHUNK = 128
D_FF = 4 * D_MODEL
PROJ_WIDTH = 3 * SB_WIDTH + 3 * SC_WIDTH + 2 * SG_WIDTH
N_MOD = 6
EPS = 1e-6

kernel_name = "hybrid_sb_conv_gmlp_adaln_trunk"


def rmsnorm(x, g):
    x32 = x.astype(jnp.float32)
    y = x32 * lax.rsqrt(jnp.mean(x32 * x32, axis=-1, keepdims=True) + EPS)
    return (y * g.astype(jnp.float32)).astype(x.dtype)


def stick_breaking_attention(q, k, v):
    bsz, seq, nh, hd = q.shape
    scale = hd ** -0.5
    q32 = q.astype(jnp.float32)
    k32 = k.astype(jnp.float32)
    v32 = v.astype(jnp.float32)
    outs = []
    for i in range(seq // SB_BLOCK):
        kv_len = (i + 1) * SB_BLOCK
        q_blk = q32[:, i * SB_BLOCK:(i + 1) * SB_BLOCK]
        k_ctx = k32[:, :kv_len]
        v_ctx = v32[:, :kv_len]
        z = jnp.einsum('bqhd,bkhd->bhqk', q_blk, k_ctx) * scale
        t_pos = i * SB_BLOCK + jnp.arange(SB_BLOCK)
        s_pos = jnp.arange(kv_len)
        mask = s_pos[None, :] < t_pos[:, None]
        log_beta = jax.nn.log_sigmoid(z)
        log_stay = jnp.where(mask, jax.nn.log_sigmoid(-z), 0.0)
        log_after = lax.cumsum(log_stay, axis=3, reverse=True) - log_stay
        w = jnp.where(mask, jnp.exp(log_beta + log_after), 0.0)
        outs.append(jnp.einsum('bhqk,bkhd->bqhd', w, v_ctx))
    return jnp.concatenate(outs, axis=1).astype(q.dtype)


def short_gated_conv(b_gate, c_gate, h, conv_w, conv_b):
    u = c_gate * h
    y = lax.conv_general_dilated(
        u, conv_w[:, None, :].astype(u.dtype), window_strides=(1,),
        padding=[(SC_KERNEL - 1, 0)], dimension_numbers=('NWC', 'WIO', 'NWC'),
        feature_group_count=SC_WIDTH)
    return b_gate * (y + conv_b)


def spatial_gating(u, v, norm_g, sw, sb):
    bsz, seq, _ = v.shape
    u = jax.nn.gelu(u)
    v = rmsnorm(jax.nn.gelu(v), norm_g)
    n_win = seq // SG_CHUNK
    v = v.reshape(bsz, n_win, SG_CHUNK, SG_HEADS, HEAD_DIM)
    chunk_id = jnp.arange(SG_CHUNK) // CHUNK
    mask = chunk_id[:, None] >= chunk_id[None, :]
    w = jnp.where(mask[None], sw, jnp.zeros_like(sw))
    mixed = jnp.einsum('hts,bnshd->bnthd', w, v) + sb.T[None, None, :, :, None]
    return u * mixed.reshape(bsz, seq, SG_WIDTH)


def setup_inputs(seed: int = 0) -> dict:
    key = jax.random.key(seed)
    ks = jax.random.split(key, 16)
    f32 = jnp.float32
    L = DEPTH
    x = jax.random.normal(ks[0], (BATCH, SEQ, D_MODEL), f32)
    c = jax.random.normal(ks[1], (BATCH, D_MODEL), f32)
    ada_w = jax.random.normal(ks[2], (L, D_MODEL, N_MOD * D_MODEL), f32) * D_MODEL ** -0.5
    ada_b = jax.random.normal(ks[3], (L, N_MOD * D_MODEL), f32) * 0.02
    norm_mix_g = 1.0 + 0.02 * jax.random.normal(ks[4], (L, D_MODEL), f32)
    norm_mlp_g = 1.0 + 0.02 * jax.random.normal(ks[5], (L, D_MODEL), f32)
    w_in = jax.random.normal(ks[6], (L, D_MODEL, PROJ_WIDTH), f32) * D_MODEL ** -0.5
    conv_w = jax.random.normal(ks[7], (L, SC_KERNEL, SC_WIDTH), f32) * SC_KERNEL ** -0.5
    conv_b = jax.random.normal(ks[8], (L, SC_WIDTH), f32) * 0.02
    gmlp_norm_g = 1.0 + 0.02 * jax.random.normal(ks[9], (L, SG_WIDTH), f32)
    spatial_w = jax.random.normal(ks[10], (L, SG_HEADS, SG_CHUNK, SG_CHUNK), f32) * SG_CHUNK ** -0.5
    spatial_b = 1.0 + 0.1 * jax.random.normal(ks[11], (L, SG_HEADS, SG_CHUNK), f32)
    w_out = jax.random.normal(ks[12], (L, D_MIX, D_MODEL), f32) * D_MIX ** -0.5
    mlp_w1 = jax.random.normal(ks[13], (L, D_MODEL, D_FF), f32) * D_MODEL ** -0.5
    mlp_w2 = jax.random.normal(ks[14], (L, D_FF, D_MODEL), f32) * D_FF ** -0.5
    final_norm_g = 1.0 + 0.02 * jax.random.normal(ks[15], (D_MODEL,), f32)
    return {"x": x, "c": c, "ada_w": ada_w, "ada_b": ada_b,
            "norm_mix_g": norm_mix_g, "norm_mlp_g": norm_mlp_g, "w_in": w_in,
            "conv_w": conv_w, "conv_b": conv_b, "gmlp_norm_g": gmlp_norm_g,
            "spatial_w": spatial_w, "spatial_b": spatial_b, "w_out": w_out,
            "mlp_w1": mlp_w1, "mlp_w2": mlp_w2, "final_norm_g": final_norm_g}


def reference(x, c, ada_w, ada_b, norm_mix_g, norm_mlp_g, w_in, conv_w, conv_b,
              gmlp_norm_g, spatial_w, spatial_b, w_out, mlp_w1, mlp_w2, final_norm_g):
    bsz, seq, _ = x.shape
    bounds = [SB_WIDTH, 2 * SB_WIDTH, 3 * SB_WIDTH,
              3 * SB_WIDTH + SC_WIDTH, 3 * SB_WIDTH + 2 * SC_WIDTH,
              3 * SB_WIDTH + 3 * SC_WIDTH, 3 * SB_WIDTH + 3 * SC_WIDTH + SG_WIDTH]
    c_act = jax.nn.silu(c)
    for l in range(DEPTH):
        mod = c_act @ ada_w[l] + ada_b[l]
        sh_m, sc_m, g_m, sh_f, sc_f, g_f = jnp.split(mod[:, None, :], N_MOD, axis=-1)

        h = rmsnorm(x, norm_mix_g[l]) * (1.0 + sc_m) + sh_m
        proj = h @ w_in[l]
        q, k, v, b_gate, c_gate, h_conv, u_sg, v_sg = jnp.split(proj, bounds, axis=-1)
        a_out = stick_breaking_attention(
            q.reshape(bsz, seq, SB_HEADS, HEAD_DIM),
            k.reshape(bsz, seq, SB_HEADS, HEAD_DIM),
            v.reshape(bsz, seq, SB_HEADS, HEAD_DIM)).reshape(bsz, seq, SB_WIDTH)
        c_out = short_gated_conv(b_gate, c_gate, h_conv, conv_w[l], conv_b[l])
        s_out = spatial_gating(u_sg, v_sg, gmlp_norm_g[l], spatial_w[l], spatial_b[l])
        mix = jnp.concatenate([a_out, c_out, s_out], axis=-1) @ w_out[l]
        x = x + g_m * mix

        h = rmsnorm(x, norm_mlp_g[l]) * (1.0 + sc_f) + sh_f
        x = x + g_f * (jnp.square(jax.nn.relu(h @ mlp_w1[l])) @ mlp_w2[l])
    return rmsnorm(x, final_norm_g)
```

```cpp
#include <hip/hip_runtime.h>
#include <hip/hip_cooperative_groups.h>
#include <cstdio>
#include <cstdint>
namespace cg = cooperative_groups;
namespace pg8 {
#define PG8_LAS __attribute__((address_space(3)))
typedef unsigned short bf16_t;
typedef short bf16x8 __attribute__((ext_vector_type(8)));
typedef float f32x4 __attribute__((ext_vector_type(4)));
typedef unsigned u32x4 __attribute__((ext_vector_type(4)));
constexpr int BM = 256, BK = 64, HALF = 128, HTB = HALF * BK * 2  , STAGE_BYTES = 8 * HTB, NXCD = 8, WGM = 8;

__host__ __device__ __forceinline__ int lds_byte(int r, int c) { const int st = (r >> 4) * 2 + (c >> 5), rr = r & 15, cc = c & 31, ob = rr * 64 + cc * 2; return st * 1024 + (ob ^ (((ob >> 9) & 1) << 5)); }
__host__ __device__ __forceinline__ void stage_rc(int b, int& R, int& C) { const int st = b / 1024, sb = b % 1024, swz = sb ^ (((sb >> 9) & 1) << 5); R = (st >> 1) * 16 + swz / 64; C = (st & 1) * 32 + (swz % 64) / 2; }
__host__ __device__ __forceinline__ int perm32(int rho) { const int n = rho >> 4, i = rho & 15; return 8 * (i >> 2) + 4 * n + (i & 3); }

struct Unit { int pm, pn; };
struct Gemm { const bf16_t* A; const bf16_t* Bt; int M, N, K; };

struct StaticOrder {
    int nM, nN, nwg, G, c;
    __host__ __device__ void init(int M, int N, int G_, int c_) { nM = M / BM; nN = N / BM; nwg = nM * nN; G = G_; c = c_; }
    __host__ __device__ bool next(int i, Unit& u) const {
        const long L = (long)i * G + c; if (L >= nwg) return false;
        int wgid = (int)L; { const int q = nwg / NXCD, r = nwg % NXCD, xcd = wgid % NXCD, off = wgid / NXCD; wgid = (xcd < r ? xcd * (q + 1) : r * (q + 1) + (xcd - r) * q) + off; }
        const int nig = WGM * nN, gid = wgid / nig, fm = gid * WGM, gsz = (nM - fm) < WGM ? (nM - fm) : WGM;
        u.pm = fm + ((wgid % nig) % gsz); u.pn = (wgid % nig) / gsz; return true;
    }
    __device__ __forceinline__ void a_ready(const Unit&) const {}
    __device__ __forceinline__ void done(const Unit&) const {}
};
__device__ __forceinline__ unsigned cvt_pk_bf16(float lo, float hi) { unsigned r; asm volatile("v_cvt_pk_bf16_f32 %0, %1, %2" : "=v"(r) : "v"(lo), "v"(hi)); return r; }

template <int ACT> struct EpiBf16 {
    static constexpr bool PERM = true, AFTER_DRAIN = false;
    bf16_t* O; int ldc;
    __device__ __forceinline__ void operator()(const f32x4 (&acc)[2][2][4][2], const Unit& u, int wr, int wc, int fr, int fq) const {
        const int row0 = u.pm * BM + wr * 64 + fr; const int col0 = u.pn * BM + wc * 32 + 8 * fq;
#pragma unroll
        for (int ai = 0; ai < 2; ++ai)
#pragma unroll
            for (int m = 0; m < 4; ++m) { bf16_t* rowp = O + (size_t)(row0 + ai * HALF + m * 16) * ldc + col0;
#pragma unroll
                for (int bj = 0; bj < 2; ++bj) { f32x4 v0 = acc[ai][bj][m][0], v1 = acc[ai][bj][m][1];
                    if (ACT == 2) {
#pragma unroll
                        for (int e = 0; e < 4; ++e) { const float a = fmaxf(v0[e], 0.f), b = fmaxf(v1[e], 0.f); v0[e] = a * a; v1[e] = b * b; } }
                    u32x4 w; w.x = cvt_pk_bf16(v0[0], v0[1]); w.y = cvt_pk_bf16(v0[2], v0[3]); w.z = cvt_pk_bf16(v1[0], v1[1]); w.w = cvt_pk_bf16(v1[2], v1[3]);
                    *(u32x4*)(rowp + bj * HALF) = w; } }
    }
};
struct EpiResGate {
    static constexpr bool PERM = false, AFTER_DRAIN = false;
    const float* base; float* out; const float* gate; int gstride;
    __device__ __forceinline__ void operator()(const f32x4 (&acc)[2][2][4][2], const Unit& u, int wr, int wc, int fr, int fq) const {
        const int col0 = u.pn * BM + wc * 32 + 4 * fq; const int b = (u.pm * BM) >> 11;
        f32x4 gv[2][2];
#pragma unroll
        for (int bj = 0; bj < 2; ++bj)
#pragma unroll
            for (int n = 0; n < 2; ++n) gv[bj][n] = *(const f32x4*)(gate + (size_t)b * gstride + col0 + bj * HALF + n * 16);
#pragma unroll
        for (int ai = 0; ai < 2; ++ai)
#pragma unroll
            for (int m = 0; m < 4; ++m) { const size_t off = (size_t)(u.pm * BM + ai * HALF + wr * 64 + m * 16 + fr) * 1024 + col0;
#pragma unroll
                for (int bj = 0; bj < 2; ++bj)
#pragma unroll
                    for (int n = 0; n < 2; ++n) { const f32x4 bs = *(const f32x4*)(base + off + bj * HALF + n * 16);
                        *(f32x4*)(out + off + bj * HALF + n * 16) = bs + gv[bj][n] * acc[ai][bj][m][n]; } }
    }
};
template <class Epi, class Sched, bool ALIGN_EPI = false, bool SP2 = false>
__device__ __forceinline__ void gemm_phase(PG8_LAS unsigned char* lds, const Gemm g, const Sched& S, const Epi& E) {
    const int tid = threadIdx.x, wid = __builtin_amdgcn_readfirstlane(tid >> 6), lane = tid & 63, wr = wid >> 2, wc = wid & 3, fr = lane & 15, fq = lane >> 4;
    const int K = g.K, nt = K / BK;
    unsigned voffA[2], voffB[2];
#pragma unroll
    for (int i = 0; i < 2; ++i) { int R, C; stage_rc(tid * 16 + i * 8192, R, C); const int Rb = Epi::PERM ? ((R & ~31) + perm32(R & 31)) : R;
        voffA[i] = (unsigned)(R * K + C) * 2u; voffB[i] = (unsigned)(Rb * K + C) * 2u; }
    const size_t kstep = (size_t)(BK * 2);
    const size_t hstep = (size_t)HALF * K * 2;
    const size_t tstep = 2 * hstep;
    const unsigned ldsw = (unsigned)wid * 1024u;
    const int aoff = lds_byte(wr * 64 + fr, fq * 8), boff = lds_byte(wc * 32 + fr, fq * 8);
#define PG8_SA(b, h) (((b) * 2 + (h)) * HTB)
#define PG8_SB(b, h) ((4 + (b) * 2 + (h)) * HTB)
#define PG8_STAGE(bufoff, gbase, voff) do { _Pragma("unroll") for (int _i = 0; _i < 2; ++_i) \
        __builtin_amdgcn_global_load_lds((const unsigned*)((const char*)(gbase) + (voff)[_i]), (PG8_LAS unsigned*)(lds + (bufoff) + ldsw + _i * 8192), 16, 0, 0); } while (0)
#define PG8_LDA(dst, b, h) do { _Pragma("unroll") for (int m = 0; m < 4; ++m) _Pragma("unroll") for (int k = 0; k < 2; ++k) dst[m][k] = *(const PG8_LAS bf16x8*)(lds + PG8_SA(b, h) + aoff + m * 2048 + k * 1024); } while (0)
#define PG8_LDB(dst, b, h) do { _Pragma("unroll") for (int n = 0; n < 2; ++n) _Pragma("unroll") for (int k = 0; k < 2; ++k) dst[n][k] = *(const PG8_LAS bf16x8*)(lds + PG8_SB(b, h) + boff + n * 2048 + k * 1024); } while (0)
#define PG8_MMA(ai, bj, At, Bt) do { __builtin_amdgcn_s_setprio(1); _Pragma("unroll") for (int m = 0; m < 4; ++m) _Pragma("unroll") for (int n = 0; n < 2; ++n) _Pragma("unroll") for (int k = 0; k < 2; ++k) \
        acc[ai][bj][m][n] = __builtin_amdgcn_mfma_f32_16x16x32_bf16(Bt[n][k], At[m][k], acc[ai][bj][m][n], 0, 0, 0); __builtin_amdgcn_s_setprio(0); } while (0)
#define PG8_WAIT_V(n) asm volatile("s_waitcnt vmcnt(" #n ")" ::: "memory")
#define PG8_WAIT_L(n) asm volatile("s_waitcnt lgkmcnt(" #n ")" ::: "memory")
#define PG8_BAR __builtin_amdgcn_s_barrier()
#define PG8_SCHED __builtin_amdgcn_sched_barrier(0)
    Unit cur, nxt; int ui = 0;
    if (!S.next(0, cur)) return;
    f32x4 acc[2][2][4][2];
#pragma unroll
    for (int a = 0; a < 2; ++a)
#pragma unroll
        for (int b = 0; b < 2; ++b)
#pragma unroll
            for (int m = 0; m < 4; ++m)
#pragma unroll
                for (int n = 0; n < 2; ++n) acc[a][b][m][n] = (f32x4){0.f, 0.f, 0.f, 0.f};
    bf16x8 At[4][2], B0[2][2], B1[2][2];
    const char* cA = (const char*)g.A + (size_t)cur.pm * tstep; const char* cB = (const char*)g.Bt + (size_t)cur.pn * tstep;
    S.a_ready(cur);
    if constexpr (SP2) {
        PG8_STAGE(PG8_SB(0, 0), cB, voffB); PG8_STAGE(PG8_SB(0, 1), cB + hstep, voffB); PG8_STAGE(PG8_SA(0, 0), cA, voffA); PG8_STAGE(PG8_SA(0, 1), cA + hstep, voffA);
        if (wr == 1) PG8_BAR;
        PG8_WAIT_V(2); PG8_BAR;
        PG8_STAGE(PG8_SB(1, 0), cB + kstep, voffB); PG8_STAGE(PG8_SA(1, 0), cA + kstep, voffA); PG8_STAGE(PG8_SB(1, 1), cB + hstep + kstep, voffB);
        PG8_WAIT_V(6); PG8_BAR;
    } else {
        PG8_STAGE(PG8_SB(0, 0), cB, voffB); PG8_STAGE(PG8_SA(0, 0), cA, voffA); PG8_STAGE(PG8_SB(0, 1), cB + hstep, voffB); PG8_STAGE(PG8_SA(0, 1), cA + hstep, voffA);
        if (wr == 1) PG8_BAR;
        PG8_WAIT_V(4); PG8_BAR;
        PG8_STAGE(PG8_SB(1, 0), cB + kstep, voffB); PG8_STAGE(PG8_SA(1, 0), cA + kstep, voffA); PG8_STAGE(PG8_SB(1, 1), cB + hstep + kstep, voffB);
        PG8_WAIT_V(6); PG8_BAR;
    }
    for (;;) {
        const bool has_next = S.next(ui + 1, nxt);
        const char* nA = has_next ? (const char*)g.A + (size_t)nxt.pm * tstep : cA; const char* nB = has_next ? (const char*)g.Bt + (size_t)nxt.pn * tstep : cB;
        for (int t = 0; t < nt; t += 2) {
            const bool last = (t == nt - 2);
            const char* a1 = cA + (size_t)(t + 1) * kstep;
            const char* a2 = last ? nA : cA + (size_t)(t + 2) * kstep; const char* b2 = last ? nB : cB + (size_t)(t + 2) * kstep;
            const char* a3 = a2 + kstep; const char* b3 = b2 + kstep;
            if (last && has_next) S.a_ready(nxt);
            if constexpr (SP2) {
            PG8_LDB(B0, 0, 0); PG8_LDB(B1, 0, 1); PG8_SCHED; PG8_LDA(At, 0, 0); PG8_STAGE(PG8_SA(1, 1), a1 + hstep, voffA);
            PG8_WAIT_V(8); PG8_WAIT_L(0); PG8_BAR; PG8_MMA(0, 0, At, B0); PG8_MMA(0, 1, At, B1); PG8_BAR; PG8_SCHED;
            PG8_LDA(At, 0, 1); PG8_STAGE(PG8_SB(0, 0), b2, voffB); PG8_STAGE(PG8_SB(0, 1), b2 + hstep, voffB); PG8_STAGE(PG8_SA(0, 0), a2, voffA);
            PG8_WAIT_V(8); PG8_WAIT_L(0); PG8_BAR; PG8_MMA(1, 0, At, B0); PG8_MMA(1, 1, At, B1); PG8_BAR; PG8_SCHED;
            PG8_LDB(B0, 1, 0); PG8_LDB(B1, 1, 1); PG8_SCHED; PG8_LDA(At, 1, 0); PG8_STAGE(PG8_SA(0, 1), a2 + hstep, voffA);
            PG8_WAIT_V(8); PG8_WAIT_L(0); PG8_BAR; PG8_MMA(0, 0, At, B0); PG8_MMA(0, 1, At, B1); PG8_BAR; PG8_SCHED;
            PG8_LDA(At, 1, 1); PG8_STAGE(PG8_SB(1, 0), b3, voffB); PG8_STAGE(PG8_SB(1, 1), b3 + hstep, voffB); PG8_STAGE(PG8_SA(1, 0), a3, voffA);
            PG8_WAIT_V(8); PG8_WAIT_L(0); PG8_BAR; PG8_MMA(1, 0, At, B0); PG8_MMA(1, 1, At, B1); PG8_BAR; PG8_SCHED;
            } else {
            PG8_LDB(B0, 0, 0); PG8_SCHED; PG8_LDA(At, 0, 0); PG8_STAGE(PG8_SA(1, 1), a1 + hstep, voffA);
            PG8_WAIT_L(8); PG8_BAR; PG8_WAIT_L(0); PG8_MMA(0, 0, At, B0); PG8_BAR; PG8_SCHED;
            PG8_LDB(B1, 0, 1); PG8_STAGE(PG8_SB(0, 0), b2, voffB);
            PG8_BAR; PG8_WAIT_L(0); PG8_MMA(0, 1, At, B1); PG8_BAR;
            PG8_LDA(At, 0, 1); PG8_STAGE(PG8_SA(0, 0), a2, voffA);
            PG8_BAR; PG8_WAIT_L(0); PG8_MMA(1, 0, At, B0); PG8_BAR; PG8_SCHED;
            PG8_STAGE(PG8_SB(0, 1), b2 + hstep, voffB);
            PG8_WAIT_V(6); PG8_BAR; PG8_MMA(1, 1, At, B1); PG8_BAR;
            PG8_LDB(B0, 1, 0); PG8_SCHED; PG8_LDA(At, 1, 0); PG8_STAGE(PG8_SA(0, 1), a2 + hstep, voffA);
            PG8_WAIT_L(8); PG8_BAR; PG8_WAIT_L(0); PG8_MMA(0, 0, At, B0); PG8_BAR; PG8_SCHED;
            PG8_LDB(B1, 1, 1); PG8_STAGE(PG8_SB(1, 0), b3, voffB);
            PG8_BAR; PG8_WAIT_L(0); PG8_MMA(0, 1, At, B1); PG8_BAR;
            PG8_LDA(At, 1, 1); PG8_STAGE(PG8_SA(1, 0), a3, voffA);
            PG8_BAR; PG8_WAIT_L(0); PG8_MMA(1, 0, At, B0); PG8_BAR; PG8_SCHED;
            PG8_STAGE(PG8_SB(1, 1), b3 + hstep, voffB);
            PG8_WAIT_V(6); PG8_BAR; PG8_MMA(1, 1, At, B1); PG8_BAR;
            }
        }
        if constexpr (ALIGN_EPI) { if (wr == 0) PG8_BAR; }
        if constexpr (!Epi::AFTER_DRAIN) { E(acc, cur, wr, wc, fr, fq); S.done(cur); }
        if (!has_next) break;
#pragma unroll
        for (int a = 0; a < 2; ++a)
#pragma unroll
            for (int b = 0; b < 2; ++b)
#pragma unroll
                for (int m = 0; m < 4; ++m)
#pragma unroll
                    for (int n = 0; n < 2; ++n) acc[a][b][m][n] = (f32x4){0.f, 0.f, 0.f, 0.f};
        cur = nxt; cA = nA; cB = nB; ++ui;
        if constexpr (ALIGN_EPI) { if (wr == 1) PG8_BAR; }
    }
    PG8_WAIT_V(0);
    if constexpr (!ALIGN_EPI) { if (wr == 0) PG8_BAR; }
    PG8_BAR;
    if constexpr (Epi::AFTER_DRAIN) { E.fused(acc, cur, wr, wc, fr, fq, lds, wid, lane); S.done(cur); }
#undef PG8_SA
#undef PG8_SB
#undef PG8_STAGE
#undef PG8_LDA
#undef PG8_LDB
#undef PG8_MMA
#undef PG8_WAIT_V
#undef PG8_WAIT_L
#undef PG8_BAR
#undef PG8_SCHED
}
}

#define LAS __attribute__((address_space(3)))
typedef unsigned short bf16;
typedef float f32x4 __attribute__((ext_vector_type(4)));
typedef float f32x16 __attribute__((ext_vector_type(16)));
typedef short bf16x8 __attribute__((ext_vector_type(8)));
typedef unsigned u32x4 __attribute__((ext_vector_type(4)));
typedef unsigned u32x2 __attribute__((ext_vector_type(2)));

constexpr int DM = 1024, NB = 8, SEQ = 2048, MTOK = NB * SEQ, PW = 2816, DFF = 4096, NMOD = 6 * DM, DEPTH = 2;
constexpr float EPS = 1e-6f;
constexpr int NWAVES = 8, NTHR = 512;
constexpr int LDS_BYTES = 147456;
constexpr size_t MiB = 1u << 20;
constexpr size_t WS_WT = 0, WT_LAYER = 24 * MiB, WT_IN = 0, WT_OUT = 6 * MiB, WT_1 = 8 * MiB, WT_2 = 16 * MiB;
constexpr size_t WS_MOD = 48 * MiB;
constexpr size_t WS_H = 49 * MiB;
constexpr size_t WS_R = 81 * MiB;
constexpr size_t WS_MIX = WS_R + 96 * MiB;
constexpr size_t WS_END = 209 * MiB;
constexpr int NPHASE = 17;

__device__ __forceinline__ float bf_lo(unsigned u) { return __uint_as_float(u << 16); }
__device__ __forceinline__ float bf_hi(unsigned u) { return __uint_as_float(u & 0xffff0000u); }
__device__ __forceinline__ float bf2f(unsigned short u) { return __uint_as_float((unsigned)u << 16); }
__device__ __forceinline__ unsigned pk_bf16(float lo, float hi) { return pg8::cvt_pk_bf16(lo, hi); }
__device__ __forceinline__ float wave_sum(float v) {
#pragma unroll
    for (int o = 1; o < 64; o <<= 1) v += __shfl_xor(v, o);
    return v;
}
__device__ __forceinline__ float gelu_tanh(float x) {
    const float y2 = x * (1.5957691216f + 0.07135481627f * x * x);
    const float e = __builtin_amdgcn_exp2f(-y2 * 1.4426950408889634f);
    return x * __builtin_amdgcn_rcpf(1.0f + e);
}
__device__ __forceinline__ int crow(int r, int hi) { return (r & 3) + 8 * (r >> 2) + 4 * hi; }

struct Args { const float* in[16]; float* out; unsigned char* ws; int ph_lo, ph_hi; };
typedef const __attribute__((address_space(4))) Args CArgs;

__device__ __forceinline__ void p0_transpose_item(const float* W, int K, int N, bf16* WT, LAS float* scr, int item, int lane) {
    const int nblk = N / 32, kb = item / nblk, nb = item % nblk, k0 = 64 * kb, n0 = 32 * nb;
#pragma unroll 8
    for (int i = 0; i < 32; ++i) { const int kk = 2 * i + (lane >> 5); scr[kk * 33 + (lane & 31)] = W[(size_t)(k0 + kk) * N + n0 + (lane & 31)]; }
    asm volatile("s_waitcnt lgkmcnt(0)" ::: "memory");
    const int c = lane & 7;
#pragma unroll
    for (int j = 0; j < 4; ++j) { const int n = (lane >> 3) + 8 * j; const LAS float* s = scr + (8 * c) * 33 + n;
        u32x4 o; o.x = pk_bf16(s[0 * 33], s[1 * 33]); o.y = pk_bf16(s[2 * 33], s[3 * 33]); o.z = pk_bf16(s[4 * 33], s[5 * 33]); o.w = pk_bf16(s[6 * 33], s[7 * 33]);
        *(u32x4*)(WT + (size_t)(n0 + n) * K + k0 + 8 * c) = o; }
    asm volatile("s_waitcnt lgkmcnt(0)" ::: "memory");
}
__device__ __forceinline__ void phase_p0a(CArgs* ap, LAS unsigned char* lds, int tid, int wave, int lane) {
    LAS float* cact = (LAS float*)lds;
    const float* c = ap->in[1];
    for (int i = tid; i < NB * DM; i += NTHR) { const float v = c[i]; cact[i] = v / (1.0f + __expf(-v)); }
    __syncthreads();
    const int gw = blockIdx.x * NWAVES + wave, NGW = gridDim.x * NWAVES;
    float* MODP = (float*)(ap->ws + WS_R);
    const float* ada_w = ap->in[2];
    for (int it = gw; it < 1536; it += NGW) {
        const int l = it / 768, r = it % 768, kc = r / 24, cgp = r % 24;
        const float* W = ada_w + (size_t)l * DM * NMOD + (size_t)(kc * 32) * NMOD + cgp * 256 + lane * 4;
        f32x4 acc[8];
#pragma unroll
        for (int b = 0; b < 8; ++b) acc[b] = (f32x4){0.f, 0.f, 0.f, 0.f};
#pragma unroll 8
        for (int k = 0; k < 32; ++k) { const f32x4 w = *(const f32x4*)(W + (size_t)k * NMOD);
#pragma unroll
            for (int b = 0; b < 8; ++b) { const float cv = cact[b * DM + kc * 32 + k]; acc[b] += w * cv; } }
#pragma unroll
        for (int b = 0; b < 8; ++b) *(f32x4*)(MODP + ((size_t)((l * 32 + kc) * 8 + b)) * NMOD + cgp * 256 + lane * 4) = acc[b];
    }
    LAS float* scr = (LAS float*)(lds + 32768 + wave * 8704);
    constexpr int I_IN = (DM / 64) * (PW / 32), I_OUT = (DM / 64) * (DM / 32), I_1 = (DM / 64) * (DFF / 32), I_2 = (DFF / 64) * (DM / 32);
    constexpr int I_LAYER = I_IN + I_OUT + I_1 + I_2;
    const int gws = (gw + NGW - (1536 % NGW)) % NGW;
    for (int it = gws; it < DEPTH * I_LAYER; it += NGW) {
        const int l = it / I_LAYER; int r = it % I_LAYER;
        unsigned char* wt = ap->ws + WS_WT + (size_t)l * WT_LAYER;
        if (r < I_IN) { p0_transpose_item(ap->in[6] + (size_t)l * DM * PW, DM, PW, (bf16*)(wt + WT_IN), scr, r, lane); continue; } r -= I_IN;
        if (r < I_OUT) { p0_transpose_item(ap->in[12] + (size_t)l * DM * DM, DM, DM, (bf16*)(wt + WT_OUT), scr, r, lane); continue; } r -= I_OUT;
        if (r < I_1) { p0_transpose_item(ap->in[13] + (size_t)l * DM * DFF, DM, DFF, (bf16*)(wt + WT_1), scr, r, lane); continue; } r -= I_1;
        p0_transpose_item(ap->in[14] + (size_t)l * DFF * DM, DFF, DM, (bf16*)(wt + WT_2), scr, r, lane);
    }
}
__device__ __forceinline__ void phase_p0b(CArgs* ap, int tid) {
    const float* MODP = (const float*)(ap->ws + WS_R); float* MOD = (float*)(ap->ws + WS_MOD); const float* ada_b = ap->in[3];
    for (int idx = blockIdx.x * NTHR + tid; idx < DEPTH * NB * NMOD; idx += gridDim.x * NTHR) {
        const int l = idx / (NB * NMOD), rem = idx % (NB * NMOD), b = rem / NMOD, col = rem % NMOD;
        float s = ada_b[l * NMOD + col];
#pragma unroll 8
        for (int kc = 0; kc < 32; ++kc) s += MODP[((size_t)((l * 32 + kc) * 8 + b)) * NMOD + col];
        MOD[idx] = s;
    }
}
__device__ __forceinline__ void phase_norm_mod(const float* x, bf16* h, const float* g, const float* shift, const float* scale, int wave, int lane) {
    const int gw = blockIdx.x * NWAVES + wave, NGW = gridDim.x * NWAVES;
    for (int m = gw; m < MTOK; m += NGW) {
        const int b = m >> 11;
        const f32x4* xr = (const f32x4*)(x + (size_t)m * DM) + lane;
        f32x4 v[4]; float s = 0.f;
#pragma unroll
        for (int j = 0; j < 4; ++j) { v[j] = xr[64 * j]; s += (v[j].x * v[j].x + v[j].y * v[j].y) + (v[j].z * v[j].z + v[j].w * v[j].w); }
        const float rstd = 1.0f / sqrtf(wave_sum(s) * (1.0f / DM) + EPS);
        unsigned long long* o8 = (unsigned long long*)(h + (size_t)m * DM) + lane;
#pragma unroll
        for (int j = 0; j < 4; ++j) {
            const f32x4 gg = *((const f32x4*)g + lane + 64 * j), sc = *((const f32x4*)(scale + (size_t)b * NMOD) + lane + 64 * j), sh = *((const f32x4*)(shift + (size_t)b * NMOD) + lane + 64 * j);
            const f32x4 y = (v[j] * rstd) * gg * (sc + 1.0f) + sh;
            o8[64 * j] = (unsigned long long)pk_bf16(y.x, y.y) | ((unsigned long long)pk_bf16(y.z, y.w) << 32);
        }
    }
}
__device__ __forceinline__ void phase_final_norm(float* x, const float* g, int wave, int lane) {
    const int gw = blockIdx.x * NWAVES + wave, NGW = gridDim.x * NWAVES;
    for (int m = gw; m < MTOK; m += NGW) {
        f32x4* xr = (f32x4*)(x + (size_t)m * DM) + lane;
        f32x4 v[4]; float s = 0.f;
#pragma unroll
        for (int j = 0; j < 4; ++j) { v[j] = xr[64 * j]; s += (v[j].x * v[j].x + v[j].y * v[j].y) + (v[j].z * v[j].z + v[j].w * v[j].w); }
        const float rstd = 1.0f / sqrtf(wave_sum(s) * (1.0f / DM) + EPS);
#pragma unroll
        for (int j = 0; j < 4; ++j) xr[64 * j] = (v[j] * rstd) * *((const f32x4*)g + lane + 64 * j);
    }
}
constexpr int WLDS = 17920;
constexpr int VNT_STRIDE = 136, VT_STRIDE = 36;
constexpr float LOG2E = 1.4426950408889634f;
__device__ __forceinline__ void attn_unit(const bf16* PROJ, bf16* MIX, int b, int h, int qt, LAS unsigned char* wl, int lane) {
    const int q32 = lane & 31, hi = lane >> 5;
    const size_t rowbase = (size_t)b * SEQ;
    const int tq = qt * 32 + q32;
    LAS unsigned short* Vt = (LAS unsigned short*)wl;
    bf16x8 qf[4];
    { const bf16* Qp = PROJ + (rowbase + tq) * PW + h * 64 + hi * 8;
#pragma unroll
      for (int d0 = 0; d0 < 4; ++d0) qf[d0] = *(const bf16x8*)(Qp + d0 * 16); }
    f32x16 o0 = {}, o1 = {};
    float carry = 0.f;
    for (int kt = qt; kt >= 0; --kt) {
        const int k0 = kt * 32;
        bf16x8 kf[4];
        { const bf16* Kp = PROJ + (rowbase + k0 + q32) * PW + 512 + h * 64 + hi * 8;
#pragma unroll
          for (int d0 = 0; d0 < 4; ++d0) kf[d0] = *(const bf16x8*)(Kp + d0 * 16); }
        bf16x8 vv[4];
#pragma unroll
        for (int i = 0; i < 4; ++i) { const int c = lane + 64 * i, key = c >> 3, dc = c & 7; vv[i] = *(const bf16x8*)(PROJ + (rowbase + k0 + key) * PW + 1024 + h * 64 + dc * 8); }
#pragma unroll
        for (int i = 0; i < 4; ++i) { const int c = lane + 64 * i, key = c >> 3, dc = c & 7;
#pragma unroll
            for (int j = 0; j < 8; ++j) Vt[(dc * 8 + j) * VT_STRIDE + key] = (unsigned short)vv[i][j]; }
        f32x16 S = {};
#pragma unroll
        for (int d0 = 0; d0 < 4; ++d0) S = __builtin_amdgcn_mfma_f32_32x32x16_bf16(kf[d0], qf[d0], S, 0, 0, 0);
        float z2[16], sp[16];
#pragma unroll
        for (int r = 0; r < 16; ++r) {
            const int key = k0 + crow(r, hi); const bool valid = key < tq;
            const float z = S[r] * (0.125f * LOG2E); z2[r] = z;
            const float e = __builtin_amdgcn_exp2f(-fabsf(z));
            const float s = fmaxf(z, 0.f) + __builtin_amdgcn_logf(1.0f + e);
            sp[r] = valid ? s : 0.f;
        }
        float T[4], U[4];
#pragma unroll
        for (int g = 0; g < 4; ++g) { sp[4 * g + 2] += sp[4 * g + 3]; sp[4 * g + 1] += sp[4 * g + 2]; sp[4 * g + 0] += sp[4 * g + 1]; T[g] = sp[4 * g]; }
#pragma unroll
        for (int g = 0; g < 4; ++g) U[g] = __shfl_xor(T[g], 32);
        float R = carry, off[4];
#pragma unroll
        for (int g = 3; g >= 0; --g) { off[g] = R + (hi == 0 ? U[g] : 0.f); R += T[g] + U[g]; }
        carry = R;
        unsigned pw[8];
#pragma unroll
        for (int r = 0; r < 16; r += 2) {
            const int key = k0 + crow(r, hi);
            float w0 = __builtin_amdgcn_exp2f(z2[r] - (sp[r] + off[r >> 2])), w1 = __builtin_amdgcn_exp2f(z2[r + 1] - (sp[r + 1] + off[r >> 2]));
            w0 = (key < tq) ? w0 : 0.f; w1 = (key + 1 < tq) ? w1 : 0.f;
            pw[r >> 1] = pk_bf16(w0, w1);
        }
        const bf16x8 pb0 = __builtin_bit_cast(bf16x8, (u32x4){pw[0], pw[1], pw[2], pw[3]}), pb1 = __builtin_bit_cast(bf16x8, (u32x4){pw[4], pw[5], pw[6], pw[7]});
        asm volatile("s_waitcnt lgkmcnt(0)" ::: "memory"); __builtin_amdgcn_wave_barrier();
#pragma unroll
        for (int dblk = 0; dblk < 2; ++dblk) {
            const LAS unsigned short* vp = Vt + (dblk * 32 + q32) * VT_STRIDE + 4 * hi;
            const u32x2 a00 = *(const LAS u32x2*)(vp), a01 = *(const LAS u32x2*)(vp + 8), a10 = *(const LAS u32x2*)(vp + 16), a11 = *(const LAS u32x2*)(vp + 24);
            const bf16x8 va0 = __builtin_bit_cast(bf16x8, (u32x4){a00.x, a00.y, a01.x, a01.y}), va1 = __builtin_bit_cast(bf16x8, (u32x4){a10.x, a10.y, a11.x, a11.y});
            if (dblk == 0) { o0 = __builtin_amdgcn_mfma_f32_32x32x16_bf16(va0, pb0, o0, 0, 0, 0); o0 = __builtin_amdgcn_mfma_f32_32x32x16_bf16(va1, pb1, o0, 0, 0, 0); }
            else           { o1 = __builtin_amdgcn_mfma_f32_32x32x16_bf16(va0, pb0, o1, 0, 0, 0); o1 = __builtin_amdgcn_mfma_f32_32x32x16_bf16(va1, pb1, o1, 0, 0, 0); }
        }
        asm volatile("s_waitcnt lgkmcnt(0)" ::: "memory"); __builtin_amdgcn_wave_barrier();
        if (__all(carry > 152.0f)) break;
    }
    bf16* Op = MIX + (rowbase + tq) * DM + h * 64 + 4 * hi;
#pragma unroll
    for (int g = 0; g < 4; ++g) {
        *(u32x2*)(Op + 8 * g) = (u32x2){pk_bf16(o0[4 * g], o0[4 * g + 1]), pk_bf16(o0[4 * g + 2], o0[4 * g + 3])};
        *(u32x2*)(Op + 32 + 8 * g) = (u32x2){pk_bf16(o1[4 * g], o1[4 * g + 1]), pk_bf16(o1[4 * g + 2], o1[4 * g + 3])};
    }
}
__device__ __forceinline__ void gate_unit(const bf16* PROJ, bf16* MIX, const float* gn, const float* sw, const float* sb, int b, int win, int h, LAS unsigned char* wl, int lane) {
    const int q32 = lane & 31, hi = lane >> 5;
    const size_t r0 = (size_t)b * SEQ + (size_t)win * 128;
    LAS unsigned short* Vnt = (LAS unsigned short*)wl;
    LAS float* rstd = (LAS float*)(wl + 17408);
    for (int p = 0; p < 4; ++p) {
        const int row = p * 32 + (lane >> 1);
        const bf16* vp = PROJ + (r0 + row) * PW + 2560 + (lane & 1) * 128;
        float ss = 0.f;
#pragma unroll 4
        for (int i = 0; i < 16; ++i) { const u32x4 v = *(const u32x4*)(vp + i * 8);
#pragma unroll
            for (int e = 0; e < 4; ++e) { const float g0 = gelu_tanh(bf_lo(v[e])), g1 = gelu_tanh(bf_hi(v[e])); ss += g0 * g0 + g1 * g1; } }
        ss += __shfl_xor(ss, 1);
        if ((lane & 1) == 0) rstd[row] = 1.0f / sqrtf(ss * (1.0f / 256.0f) + EPS);
    }
    asm volatile("s_waitcnt lgkmcnt(0)" ::: "memory"); __builtin_amdgcn_wave_barrier();
    for (int i = 0; i < 16; ++i) {
        const int it = lane + 64 * i, s = it >> 3, dc = it & 7;
        const u32x4 v = *(const u32x4*)(PROJ + (r0 + s) * PW + 2560 + h * 64 + dc * 8);
        const float rs = rstd[s];
#pragma unroll
        for (int e = 0; e < 4; ++e) {
            const int d = dc * 8 + 2 * e;
            const float y0 = gelu_tanh(bf_lo(v[e])) * rs * gn[h * 64 + d], y1 = gelu_tanh(bf_hi(v[e])) * rs * gn[h * 64 + d + 1];
            const unsigned pk = pk_bf16(y0, y1);
            Vnt[d * VNT_STRIDE + s] = (unsigned short)(pk & 0xffffu); Vnt[(d + 1) * VNT_STRIDE + s] = (unsigned short)(pk >> 16);
        }
    }
    asm volatile("s_waitcnt lgkmcnt(0)" ::: "memory"); __builtin_amdgcn_wave_barrier();
    const float* Wh = sw + (size_t)h * 128 * 128;
    for (int tb = 0; tb < 4; ++tb) {
        const int t = tb * 32 + q32;
        f32x16 c0 = {}, c1 = {};
        const int nks = (tb < 2) ? 4 : 8;
        for (int ks = 0; ks < nks; ++ks) {
            const int s0 = ks * 16 + 8 * hi;
            const f32x4 w0 = *(const f32x4*)(Wh + (size_t)t * 128 + s0), w1 = *(const f32x4*)(Wh + (size_t)t * 128 + s0 + 4);
            const bf16x8 wb = __builtin_bit_cast(bf16x8, (u32x4){pk_bf16(w0.x, w0.y), pk_bf16(w0.z, w0.w), pk_bf16(w1.x, w1.y), pk_bf16(w1.z, w1.w)});
            const bf16x8 a0 = *(const LAS bf16x8*)(Vnt + q32 * VNT_STRIDE + s0), a1 = *(const LAS bf16x8*)(Vnt + (32 + q32) * VNT_STRIDE + s0);
            c0 = __builtin_amdgcn_mfma_f32_32x32x16_bf16(a0, wb, c0, 0, 0, 0);
            c1 = __builtin_amdgcn_mfma_f32_32x32x16_bf16(a1, wb, c1, 0, 0, 0);
        }
        const float bias = sb[h * 128 + t];
        const bf16* up = PROJ + (r0 + t) * PW + 2304 + h * 64 + 4 * hi;
        bf16* op = MIX + (r0 + t) * DM + 768 + h * 64 + 4 * hi;
#pragma unroll
        for (int g = 0; g < 4; ++g) {
            const u32x2 u0 = *(const u32x2*)(up + 8 * g), u1 = *(const u32x2*)(up + 32 + 8 * g);
            const float a = gelu_tanh(bf_lo(u0.x)) * (c0[4 * g] + bias), bb = gelu_tanh(bf_hi(u0.x)) * (c0[4 * g + 1] + bias), c = gelu_tanh(bf_lo(u0.y)) * (c0[4 * g + 2] + bias), d = gelu_tanh(bf_hi(u0.y)) * (c0[4 * g + 3] + bias);
            *(u32x2*)(op + 8 * g) = (u32x2){pk_bf16(a, bb), pk_bf16(c, d)};
            const float a2 = gelu_tanh(bf_lo(u1.x)) * (c1[4 * g] + bias), b2 = gelu_tanh(bf_hi(u1.x)) * (c1[4 * g + 1] + bias), c2 = gelu_tanh(bf_lo(u1.y)) * (c1[4 * g + 2] + bias), d2 = gelu_tanh(bf_hi(u1.y)) * (c1[4 * g + 3] + bias);
            *(u32x2*)(op + 32 + 8 * g) = (u32x2){pk_bf16(a2, b2), pk_bf16(c2, d2)};
        }
    }
    asm volatile("s_waitcnt lgkmcnt(0)" ::: "memory"); __builtin_amdgcn_wave_barrier();
}
__device__ __forceinline__ void conv_unit(const bf16* PROJ, bf16* MIX, const float* cw, const float* cb, int unit, int lane) {
    const size_t R0 = (size_t)unit * 32; const int ch = lane * 4;
    const f32x4 w0 = *(const f32x4*)(cw + ch), w1 = *(const f32x4*)(cw + 256 + ch), w2 = *(const f32x4*)(cw + 512 + ch), bb = *(const f32x4*)(cb + ch);
    f32x4 um2 = {0.f, 0.f, 0.f, 0.f}, um1 = {0.f, 0.f, 0.f, 0.f};
    auto ld4 = [&](const bf16* p) { const u32x2 v = *(const u32x2*)p; return (f32x4){bf_lo(v.x), bf_hi(v.x), bf_lo(v.y), bf_hi(v.y)}; };
    if ((R0 & (SEQ - 1)) != 0) {
        um2 = ld4(PROJ + (R0 - 2) * PW + 1792 + ch) * ld4(PROJ + (R0 - 2) * PW + 2048 + ch);
        um1 = ld4(PROJ + (R0 - 1) * PW + 1792 + ch) * ld4(PROJ + (R0 - 1) * PW + 2048 + ch);
    }
#pragma unroll 4
    for (int i = 0; i < 32; ++i) {
        const bf16* rp = PROJ + (R0 + i) * PW;
        const f32x4 bg = ld4(rp + 1536 + ch), u = ld4(rp + 1792 + ch) * ld4(rp + 2048 + ch);
        const f32x4 y = bg * (w0 * um2 + w1 * um1 + w2 * u + bb);
        *(u32x2*)(MIX + (R0 + i) * DM + 512 + ch) = (u32x2){pk_bf16(y.x, y.y), pk_bf16(y.z, y.w)};
        um2 = um1; um1 = u;
    }
}
__device__ __forceinline__ void phase_mixers(CArgs* ap, int l, LAS unsigned char* lds, int wave, int lane) {
    const bf16* PROJ = (const bf16*)(ap->ws + WS_R); bf16* MIX = (bf16*)(ap->ws + WS_MIX);
    LAS unsigned char* wl = lds + wave * WLDS;
    const int gw = blockIdx.x * NWAVES + wave, NGW = gridDim.x * NWAVES;
    constexpr int NG = NB * 16 * 4, NA = NB * 8 * 64, NC = MTOK / 32;
    for (int it = gw; it < NG + NA + NC; it += NGW) {
        if (it < NG) { const int b = it >> 6, win = (it >> 2) & 15, h = it & 3;
            gate_unit(PROJ, MIX, ap->in[9] + l * 256, ap->in[10] + (size_t)l * 4 * 128 * 128, ap->in[11] + l * 4 * 128, b, win, h, wl, lane); }
        else if (it < NG + NA) { const int u = it - NG; const int qt = 63 - (u >> 6), bh = u & 63;
            attn_unit(PROJ, MIX, bh >> 3, bh & 7, qt, wl, lane); }
        else { conv_unit(PROJ, MIX, ap->in[7] + l * 3 * 256, ap->in[8] + l * 256, it - NG - NA, lane); }
    }
}

__global__ void __launch_bounds__(NTHR, 2) trunk_fwd(Args a_unused) {
    extern __shared__ __attribute__((aligned(16))) unsigned char lds_raw[];
    LAS unsigned char* lds = (LAS unsigned char*)lds_raw;
    cg::grid_group grid = cg::this_grid();
    CArgs* kp = (CArgs*)__builtin_amdgcn_kernarg_segment_ptr();
    const int lo = kp->ph_lo, hi = kp->ph_hi;
#define KA CArgs* ap = kp; asm volatile("" : "+s"(ap));
#define TIDS int tid = threadIdx.x; asm volatile("" : "+v"(tid)); const int lane = tid & 63, wave = __builtin_amdgcn_readfirstlane(tid >> 6); (void)lane; (void)wave;
#define IN(k) (lo <= (k) && (k) < hi)
#define SEAM(k) do { if ((k) + 1 < hi) grid.sync(); } while (0)
    if (IN(0)) { TIDS; KA; phase_p0a(ap, lds, tid, wave, lane); SEAM(0); }
    if (IN(1)) { TIDS; KA; phase_p0b(ap, tid); SEAM(1); }
#pragma unroll 1
    for (int l0 = 0; l0 < DEPTH; ++l0) {
        const int p = 2 + 7 * l0;
#define LPTRS KA; int l = l0; asm volatile("" : "+s"(l)); const float* mod = (const float*)(ap->ws + WS_MOD) + (size_t)l * NB * NMOD; const unsigned char* wt = ap->ws + WS_WT + (size_t)l * WT_LAYER; const float* xin = (l == 0) ? ap->in[0] : ap->out; float* X = ap->out; \
        bf16* H = (bf16*)(ap->ws + WS_H); bf16* PROJ = (bf16*)(ap->ws + WS_R); bf16* MIX = (bf16*)(ap->ws + WS_MIX); bf16* A1 = (bf16*)(ap->ws + WS_R); (void)mod; (void)wt; (void)xin; (void)X; (void)H; (void)PROJ; (void)MIX; (void)A1;
        if (IN(p + 0)) { TIDS; LPTRS; phase_norm_mod(xin, H, ap->in[4] + l * DM, mod + 0 * DM, mod + 1 * DM, wave, lane); SEAM(p + 0); }
        if (IN(p + 1)) { __syncthreads(); LPTRS;
            pg8::Gemm g{H, (const bf16*)(wt + WT_IN), MTOK, PW, DM}; pg8::StaticOrder S; S.init(MTOK, PW, gridDim.x, blockIdx.x);
            pg8::EpiBf16<0> E{PROJ, PW};
            pg8::gemm_phase<pg8::EpiBf16<0>, pg8::StaticOrder, true, true>(lds, g, S, E); SEAM(p + 1); }
        if (IN(p + 2)) { __syncthreads(); TIDS; LPTRS; phase_mixers(ap, l, lds, wave, lane); SEAM(p + 2); }
        if (IN(p + 3)) { __syncthreads(); LPTRS;
            pg8::Gemm g{MIX, (const bf16*)(wt + WT_OUT), MTOK, DM, DM}; pg8::StaticOrder S; S.init(MTOK, DM, gridDim.x, blockIdx.x);
            pg8::EpiResGate E{xin, X, mod + 2 * DM, NMOD};
            pg8::gemm_phase<pg8::EpiResGate, pg8::StaticOrder, true, true>(lds, g, S, E); SEAM(p + 3); }
        if (IN(p + 4)) { TIDS; LPTRS; phase_norm_mod(X, H, ap->in[5] + l * DM, mod + 3 * DM, mod + 4 * DM, wave, lane); SEAM(p + 4); }
        if (IN(p + 5)) { __syncthreads(); LPTRS;
            pg8::Gemm g{H, (const bf16*)(wt + WT_1), MTOK, DFF, DM}; pg8::StaticOrder S; S.init(MTOK, DFF, gridDim.x, blockIdx.x);
            pg8::EpiBf16<2> E{A1, DFF};
            pg8::gemm_phase<pg8::EpiBf16<2>, pg8::StaticOrder, true, true>(lds, g, S, E); SEAM(p + 5); }
        if (IN(p + 6)) { __syncthreads(); LPTRS;
            pg8::Gemm g{A1, (const bf16*)(wt + WT_2), MTOK, DM, DFF}; pg8::StaticOrder S; S.init(MTOK, DM, gridDim.x, blockIdx.x);
            pg8::EpiResGate E{X, X, mod + 5 * DM, NMOD};
            pg8::gemm_phase<pg8::EpiResGate, pg8::StaticOrder, true, true>(lds, g, S, E); SEAM(p + 6); }
    }
    if (IN(16)) { TIDS; KA; phase_final_norm(ap->out, ap->in[15], wave, lane); }
#undef IN
#undef SEAM
}

#ifndef MK_N_LAUNCHES
#define MK_N_LAUNCHES 1
#endif
extern "C" void kernel_launch(void* const* d_in, const int* in_sizes, int n_in, void* d_out, int out_size, void* d_ws, size_t ws_size, hipStream_t stream) {
    static int grid = 0;
    if (grid == 0) {
        if (n_in != 16 || out_size != MTOK * DM || ws_size < WS_END) { fprintf(stderr, "kernel_launch: unexpected shapes (n_in %d out %d ws %zu)\n", n_in, out_size, ws_size); grid = -1; return; }
        int dev = 0, cus = 0, per_cu = 0;
        hipGetDevice(&dev); hipDeviceGetAttribute(&cus, hipDeviceAttributeMultiprocessorCount, dev);
        hipFuncSetAttribute((const void*)trunk_fwd, hipFuncAttributeMaxDynamicSharedMemorySize, LDS_BYTES);
        if (hipOccupancyMaxActiveBlocksPerMultiprocessor(&per_cu, (const void*)trunk_fwd, NTHR, LDS_BYTES) != hipSuccess || per_cu < 1) { fprintf(stderr, "kernel_launch: occupancy query failed (%d)\n", per_cu); (void)hipGetLastError(); per_cu = 1; }
        grid = cus * (per_cu > 1 ? 1 : per_cu);
    }
    if (grid < 0) return;
    Args a{};
    for (int i = 0; i < 16; ++i) a.in[i] = (const float*)d_in[i];
    a.out = (float*)d_out; a.ws = (unsigned char*)d_ws;
#if MK_N_LAUNCHES == 1
    a.ph_lo = 0; a.ph_hi = NPHASE;
    { void* args[] = {&a}; hipError_t e = hipLaunchCooperativeKernel((const void*)trunk_fwd, dim3(grid), dim3(NTHR), args, LDS_BYTES, stream);
      if (e != hipSuccess) fprintf(stderr, "cooperative launch failed: %s (grid %d)\n", hipGetErrorString(e), grid); }
#else
    for (int p = 0; p < NPHASE; ++p) { a.ph_lo = p; a.ph_hi = p + 1; void* args[] = {&a};
        hipError_t e = hipLaunchCooperativeKernel((const void*)trunk_fwd, dim3(grid), dim3(NTHR), args, LDS_BYTES, stream);
        if (e != hipSuccess) { fprintf(stderr, "launch %d failed: %s\n", p, hipGetErrorString(e)); break; } }
#endif
}
```

```cpp
#include <hip/hip_runtime.h>
#include <hip/hip_cooperative_groups.h>
#include <cstdio>
#include <cstdint>
namespace cg = cooperative_groups;
namespace pg8 {
#define PG8_LAS __attribute__((address_space(3)))
typedef unsigned short bf16_t;
typedef short bf16x8 __attribute__((ext_vector_type(8)));
typedef float f32x4 __attribute__((ext_vector_type(4)));
typedef unsigned u32x4 __attribute__((ext_vector_type(4)));
constexpr int BM = 256, BK = 64, HALF = 128, HTB = HALF * BK * 2  , STAGE_BYTES = 8 * HTB, NXCD = 8, WGM = 8;

__host__ __device__ __forceinline__ int lds_byte(int r, int c) { const int st = (r >> 4) * 2 + (c >> 5), rr = r & 15, cc = c & 31, ob = rr * 64 + cc * 2; return st * 1024 + (ob ^ (((ob >> 9) & 1) << 5)); }
__host__ __device__ __forceinline__ void stage_rc(int b, int& R, int& C) { const int st = b / 1024, sb = b % 1024, swz = sb ^ (((sb >> 9) & 1) << 5); R = (st >> 1) * 16 + swz / 64; C = (st & 1) * 32 + (swz % 64) / 2; }
__host__ __device__ __forceinline__ int perm32(int rho) { const int n = rho >> 4, i = rho & 15; return 8 * (i >> 2) + 4 * n + (i & 3); }

struct Unit { int pm, pn; };
struct Gemm { const bf16_t* A; const bf16_t* Bt; int M, N, K; };

struct StaticOrder {
    int nM, nN, nwg, G, c;
    __host__ __device__ void init(int M, int N, int G_, int c_) { nM = M / BM; nN = N / BM; nwg = nM * nN; G = G_; c = c_; }
    __host__ __device__ bool next(int i, Unit& u) const {
        const long L = (long)i * G + c; if (L >= nwg) return false;
        int wgid = (int)L; { const int q = nwg / NXCD, r = nwg % NXCD, xcd = wgid % NXCD, off = wgid / NXCD; wgid = (xcd < r ? xcd * (q + 1) : r * (q + 1) + (xcd - r) * q) + off; }
        const int nig = WGM * nN, gid = wgid / nig, fm = gid * WGM, gsz = (nM - fm) < WGM ? (nM - fm) : WGM;
        u.pm = fm + ((wgid % nig) % gsz); u.pn = (wgid % nig) / gsz; return true;
    }
    __device__ __forceinline__ void a_ready(const Unit&) const {}
    __device__ __forceinline__ void done(const Unit&) const {}
};
__device__ __forceinline__ unsigned cvt_pk_bf16(float lo, float hi) { unsigned r; asm volatile("v_cvt_pk_bf16_f32 %0, %1, %2" : "=v"(r) : "v"(lo), "v"(hi)); return r; }

template <int ACT> struct EpiBf16 {
    static constexpr bool PERM = true, AFTER_DRAIN = false;
    bf16_t* O; int ldc;
    __device__ __forceinline__ void operator()(const f32x4 (&acc)[2][2][4][2], const Unit& u, int wr, int wc, int fr, int fq) const {
        const int row0 = u.pm * BM + wr * 64 + fr; const int col0 = u.pn * BM + wc * 32 + 8 * fq;
#pragma unroll
        for (int ai = 0; ai < 2; ++ai)
#pragma unroll
            for (int m = 0; m < 4; ++m) { bf16_t* rowp = O + (size_t)(row0 + ai * HALF + m * 16) * ldc + col0;
#pragma unroll
                for (int bj = 0; bj < 2; ++bj) { f32x4 v0 = acc[ai][bj][m][0], v1 = acc[ai][bj][m][1];
                    if (ACT == 2) {
#pragma unroll
                        for (int e = 0; e < 4; ++e) { const float a = fmaxf(v0[e], 0.f), b = fmaxf(v1[e], 0.f); v0[e] = a * a; v1[e] = b * b; } }
                    u32x4 w; w.x = cvt_pk_bf16(v0[0], v0[1]); w.y = cvt_pk_bf16(v0[2], v0[3]); w.z = cvt_pk_bf16(v1[0], v1[1]); w.w = cvt_pk_bf16(v1[2], v1[3]);
                    *(u32x4*)(rowp + bj * HALF) = w; } }
    }
};
struct EpiResGate {
    static constexpr bool PERM = false, AFTER_DRAIN = false;
    const float* base; float* out; const float* gate; int gstride;
    __device__ __forceinline__ void operator()(const f32x4 (&acc)[2][2][4][2], const Unit& u, int wr, int wc, int fr, int fq) const {
        const int col0 = u.pn * BM + wc * 32 + 4 * fq; const int b = (u.pm * BM) >> 11;
        f32x4 gv[2][2];
#pragma unroll
        for (int bj = 0; bj < 2; ++bj)
#pragma unroll
            for (int n = 0; n < 2; ++n) gv[bj][n] = *(const f32x4*)(gate + (size_t)b * gstride + col0 + bj * HALF + n * 16);
#pragma unroll
        for (int ai = 0; ai < 2; ++ai)
#pragma unroll
            for (int m = 0; m < 4; ++m) { const size_t off = (size_t)(u.pm * BM + ai * HALF + wr * 64 + m * 16 + fr) * 1024 + col0;
#pragma unroll
                for (int bj = 0; bj < 2; ++bj)
#pragma unroll
                    for (int n = 0; n < 2; ++n) { const f32x4 bs = *(const f32x4*)(base + off + bj * HALF + n * 16);
                        *(f32x4*)(out + off + bj * HALF + n * 16) = bs + gv[bj][n] * acc[ai][bj][m][n]; } }
    }
};

struct EpiNull {
    static constexpr bool PERM = false, AFTER_DRAIN = false;
    float* out;
    __device__ __forceinline__ void operator()(const f32x4 (&acc)[2][2][4][2], const Unit& u, int wr, int wc, int fr, int fq) const {
        f32x4 s = {0.f, 0.f, 0.f, 0.f};
#pragma unroll
        for (int ai = 0; ai < 2; ++ai)
#pragma unroll
            for (int bj = 0; bj < 2; ++bj)
#pragma unroll
                for (int m = 0; m < 4; ++m)
#pragma unroll
                    for (int n = 0; n < 2; ++n) s += acc[ai][bj][m][n];
        if (s[0] + s[1] + s[2] + s[3] == 1.2345678e33f) out[0] = s[0];
    }
};
template <class Epi, class Sched, bool ALIGN_EPI = false, bool SP2 = false>
__device__ __forceinline__ void gemm_phase(PG8_LAS unsigned char* lds, const Gemm g, const Sched& S, const Epi& E) {
    const int tid = threadIdx.x, wid = __builtin_amdgcn_readfirstlane(tid >> 6), lane = tid & 63, wr = wid >> 2, wc = wid & 3, fr = lane & 15, fq = lane >> 4;
    const int K = g.K, nt = K / BK;
    unsigned voffA[2], voffB[2];
#pragma unroll
    for (int i = 0; i < 2; ++i) { int R, C; stage_rc(tid * 16 + i * 8192, R, C); const int Rb = Epi::PERM ? ((R & ~31) + perm32(R & 31)) : R;
        voffA[i] = (unsigned)(R * K + C) * 2u; voffB[i] = (unsigned)(Rb * K + C) * 2u; }
    const size_t kstep = (size_t)(BK * 2);
    const size_t hstep = (size_t)HALF * K * 2;
    const size_t tstep = 2 * hstep;
    const unsigned ldsw = (unsigned)wid * 1024u;
    const int aoff = lds_byte(wr * 64 + fr, fq * 8), boff = lds_byte(wc * 32 + fr, fq * 8);
#define PG8_SA(b, h) (((b) * 2 + (h)) * HTB)
#define PG8_SB(b, h) ((4 + (b) * 2 + (h)) * HTB)
#define PG8_STAGE(bufoff, gbase, voff) do { _Pragma("unroll") for (int _i = 0; _i < 2; ++_i) \
        __builtin_amdgcn_global_load_lds((const unsigned*)((const char*)(gbase) + (voff)[_i]), (PG8_LAS unsigned*)(lds + (bufoff) + ldsw + _i * 8192), 16, 0, 0); } while (0)
#define PG8_LDA(dst, b, h) do { _Pragma("unroll") for (int m = 0; m < 4; ++m) _Pragma("unroll") for (int k = 0; k < 2; ++k) dst[m][k] = *(const PG8_LAS bf16x8*)(lds + PG8_SA(b, h) + aoff + m * 2048 + k * 1024); } while (0)
#define PG8_LDB(dst, b, h) do { _Pragma("unroll") for (int n = 0; n < 2; ++n) _Pragma("unroll") for (int k = 0; k < 2; ++k) dst[n][k] = *(const PG8_LAS bf16x8*)(lds + PG8_SB(b, h) + boff + n * 2048 + k * 1024); } while (0)
#define PG8_MMA(ai, bj, At, Bt) do { __builtin_amdgcn_s_setprio(1); _Pragma("unroll") for (int m = 0; m < 4; ++m) _Pragma("unroll") for (int n = 0; n < 2; ++n) _Pragma("unroll") for (int k = 0; k < 2; ++k) \
        acc[ai][bj][m][n] = __builtin_amdgcn_mfma_f32_16x16x32_bf16(Bt[n][k], At[m][k], acc[ai][bj][m][n], 0, 0, 0); __builtin_amdgcn_s_setprio(0); } while (0)
#define PG8_WAIT_V(n) asm volatile("s_waitcnt vmcnt(" #n ")" ::: "memory")
#define PG8_WAIT_L(n) asm volatile("s_waitcnt lgkmcnt(" #n ")" ::: "memory")
#define PG8_BAR __builtin_amdgcn_s_barrier()
#define PG8_SCHED __builtin_amdgcn_sched_barrier(0)
    Unit cur, nxt; int ui = 0;
    if (!S.next(0, cur)) return;
    f32x4 acc[2][2][4][2];
#pragma unroll
    for (int a = 0; a < 2; ++a)
#pragma unroll
        for (int b = 0; b < 2; ++b)
#pragma unroll
            for (int m = 0; m < 4; ++m)
#pragma unroll
                for (int n = 0; n < 2; ++n) acc[a][b][m][n] = (f32x4){0.f, 0.f, 0.f, 0.f};
    bf16x8 At[4][2], B0[2][2], B1[2][2];
    const char* cA = (const char*)g.A + (size_t)cur.pm * tstep; const char* cB = (const char*)g.Bt + (size_t)cur.pn * tstep;
    S.a_ready(cur);
    if constexpr (SP2) {
        PG8_STAGE(PG8_SB(0, 0), cB, voffB); PG8_STAGE(PG8_SB(0, 1), cB + hstep, voffB); PG8_STAGE(PG8_SA(0, 0), cA, voffA); PG8_STAGE(PG8_SA(0, 1), cA + hstep, voffA);
        if (wr == 1) PG8_BAR;
        PG8_WAIT_V(2); PG8_BAR;
        PG8_STAGE(PG8_SB(1, 0), cB + kstep, voffB); PG8_STAGE(PG8_SA(1, 0), cA + kstep, voffA); PG8_STAGE(PG8_SB(1, 1), cB + hstep + kstep, voffB);
        PG8_WAIT_V(6); PG8_BAR;
    } else {
        PG8_STAGE(PG8_SB(0, 0), cB, voffB); PG8_STAGE(PG8_SA(0, 0), cA, voffA); PG8_STAGE(PG8_SB(0, 1), cB + hstep, voffB); PG8_STAGE(PG8_SA(0, 1), cA + hstep, voffA);
        if (wr == 1) PG8_BAR;
        PG8_WAIT_V(4); PG8_BAR;
        PG8_STAGE(PG8_SB(1, 0), cB + kstep, voffB); PG8_STAGE(PG8_SA(1, 0), cA + kstep, voffA); PG8_STAGE(PG8_SB(1, 1), cB + hstep + kstep, voffB);
        PG8_WAIT_V(6); PG8_BAR;
    }
    for (;;) {
        const bool has_next = S.next(ui + 1, nxt);
        const char* nA = has_next ? (const char*)g.A + (size_t)nxt.pm * tstep : cA; const char* nB = has_next ? (const char*)g.Bt + (size_t)nxt.pn * tstep : cB;
        for (int t = 0; t < nt; t += 2) {
            const bool last = (t == nt - 2);
            const char* a1 = cA + (size_t)(t + 1) * kstep;
            const char* a2 = last ? nA : cA + (size_t)(t + 2) * kstep; const char* b2 = last ? nB : cB + (size_t)(t + 2) * kstep;
            const char* a3 = a2 + kstep; const char* b3 = b2 + kstep;
            if (last && has_next) S.a_ready(nxt);
            if constexpr (SP2) {
            PG8_LDB(B0, 0, 0); PG8_LDB(B1, 0, 1); PG8_SCHED; PG8_LDA(At, 0, 0); PG8_STAGE(PG8_SA(1, 1), a1 + hstep, voffA);
            PG8_WAIT_V(8); PG8_WAIT_L(0); PG8_BAR; PG8_MMA(0, 0, At, B0); PG8_MMA(0, 1, At, B1); PG8_BAR; PG8_SCHED;
            PG8_LDA(At, 0, 1); PG8_STAGE(PG8_SB(0, 0), b2, voffB); PG8_STAGE(PG8_SB(0, 1), b2 + hstep, voffB); PG8_STAGE(PG8_SA(0, 0), a2, voffA);
            PG8_WAIT_V(8); PG8_WAIT_L(0); PG8_BAR; PG8_MMA(1, 0, At, B0); PG8_MMA(1, 1, At, B1); PG8_BAR; PG8_SCHED;
            PG8_LDB(B0, 1, 0); PG8_LDB(B1, 1, 1); PG8_SCHED; PG8_LDA(At, 1, 0); PG8_STAGE(PG8_SA(0, 1), a2 + hstep, voffA);
            PG8_WAIT_V(8); PG8_WAIT_L(0); PG8_BAR; PG8_MMA(0, 0, At, B0); PG8_MMA(0, 1, At, B1); PG8_BAR; PG8_SCHED;
            PG8_LDA(At, 1, 1); PG8_STAGE(PG8_SB(1, 0), b3, voffB); PG8_STAGE(PG8_SB(1, 1), b3 + hstep, voffB); PG8_STAGE(PG8_SA(1, 0), a3, voffA);
            PG8_WAIT_V(8); PG8_WAIT_L(0); PG8_BAR; PG8_MMA(1, 0, At, B0); PG8_MMA(1, 1, At, B1); PG8_BAR; PG8_SCHED;
            } else {
            PG8_LDB(B0, 0, 0); PG8_SCHED; PG8_LDA(At, 0, 0); PG8_STAGE(PG8_SA(1, 1), a1 + hstep, voffA);
            PG8_WAIT_L(8); PG8_BAR; PG8_WAIT_L(0); PG8_MMA(0, 0, At, B0); PG8_BAR; PG8_SCHED;
            PG8_LDB(B1, 0, 1); PG8_STAGE(PG8_SB(0, 0), b2, voffB);
            PG8_BAR; PG8_WAIT_L(0); PG8_MMA(0, 1, At, B1); PG8_BAR;
            PG8_LDA(At, 0, 1); PG8_STAGE(PG8_SA(0, 0), a2, voffA);
            PG8_BAR; PG8_WAIT_L(0); PG8_MMA(1, 0, At, B0); PG8_BAR; PG8_SCHED;
            PG8_STAGE(PG8_SB(0, 1), b2 + hstep, voffB);
            PG8_WAIT_V(6); PG8_BAR; PG8_MMA(1, 1, At, B1); PG8_BAR;
            PG8_LDB(B0, 1, 0); PG8_SCHED; PG8_LDA(At, 1, 0); PG8_STAGE(PG8_SA(0, 1), a2 + hstep, voffA);
            PG8_WAIT_L(8); PG8_BAR; PG8_WAIT_L(0); PG8_MMA(0, 0, At, B0); PG8_BAR; PG8_SCHED;
            PG8_LDB(B1, 1, 1); PG8_STAGE(PG8_SB(1, 0), b3, voffB);
            PG8_BAR; PG8_WAIT_L(0); PG8_MMA(0, 1, At, B1); PG8_BAR;
            PG8_LDA(At, 1, 1); PG8_STAGE(PG8_SA(1, 0), a3, voffA);
            PG8_BAR; PG8_WAIT_L(0); PG8_MMA(1, 0, At, B0); PG8_BAR; PG8_SCHED;
            PG8_STAGE(PG8_SB(1, 1), b3 + hstep, voffB);
            PG8_WAIT_V(6); PG8_BAR; PG8_MMA(1, 1, At, B1); PG8_BAR;
            }
        }
        if constexpr (ALIGN_EPI) { if (wr == 0) PG8_BAR; }
        if constexpr (!Epi::AFTER_DRAIN) { E(acc, cur, wr, wc, fr, fq); S.done(cur); }
        if (!has_next) break;
#pragma unroll
        for (int a = 0; a < 2; ++a)
#pragma unroll
            for (int b = 0; b < 2; ++b)
#pragma unroll
                for (int m = 0; m < 4; ++m)
#pragma unroll
                    for (int n = 0; n < 2; ++n) acc[a][b][m][n] = (f32x4){0.f, 0.f, 0.f, 0.f};
        cur = nxt; cA = nA; cB = nB; ++ui;
        if constexpr (ALIGN_EPI) { if (wr == 1) PG8_BAR; }
    }
    PG8_WAIT_V(0);
    if constexpr (!ALIGN_EPI) { if (wr == 0) PG8_BAR; }
    PG8_BAR;
    if constexpr (Epi::AFTER_DRAIN) { E.fused(acc, cur, wr, wc, fr, fq, lds, wid, lane); S.done(cur); }
#undef PG8_SA
#undef PG8_SB
#undef PG8_STAGE
#undef PG8_LDA
#undef PG8_LDB
#undef PG8_MMA
#undef PG8_WAIT_V
#undef PG8_WAIT_L
#undef PG8_BAR
#undef PG8_SCHED
}
}

#define LAS __attribute__((address_space(3)))
typedef unsigned short bf16;
typedef float f32x4 __attribute__((ext_vector_type(4)));
typedef float f32x16 __attribute__((ext_vector_type(16)));
typedef short bf16x8 __attribute__((ext_vector_type(8)));
typedef unsigned u32x4 __attribute__((ext_vector_type(4)));
typedef unsigned u32x2 __attribute__((ext_vector_type(2)));

constexpr int DM = 1024, NB = 8, SEQ = 2048, MTOK = NB * SEQ, PW = 2816, DFF = 4096, NMOD = 6 * DM, DEPTH = 2;
constexpr float EPS = 1e-6f;
constexpr int NWAVES = 8, NTHR = 512;
constexpr int LDS_BYTES = 147456;
constexpr size_t MiB = 1u << 20;
constexpr size_t WS_WT = 0, WT_LAYER = 24 * MiB, WT_IN = 0, WT_OUT = 6 * MiB, WT_1 = 8 * MiB, WT_2 = 16 * MiB;
constexpr size_t WS_MOD = 48 * MiB;
constexpr size_t WS_CTL = 48 * MiB + 512 * 1024, CTL_BYTES = 16384;
constexpr int MISC_OFF = 143360;
constexpr size_t WS_H = 49 * MiB;
constexpr size_t WS_R = 81 * MiB;
constexpr size_t WS_MIX = WS_R + 96 * MiB;
constexpr size_t WS_END = 209 * MiB;
constexpr int NPHASE = 17;

__device__ __forceinline__ float bf_lo(unsigned u) { return __uint_as_float(u << 16); }
__device__ __forceinline__ float bf_hi(unsigned u) { return __uint_as_float(u & 0xffff0000u); }
__device__ __forceinline__ float bf2f(unsigned short u) { return __uint_as_float((unsigned)u << 16); }
__device__ __forceinline__ unsigned pk_bf16(float lo, float hi) { return pg8::cvt_pk_bf16(lo, hi); }
__device__ __forceinline__ float wave_sum(float v) {
#pragma unroll
    for (int o = 1; o < 64; o <<= 1) v += __shfl_xor(v, o);
    return v;
}
__device__ __forceinline__ float gelu_tanh(float x) {
    const float y2 = x * (1.5957691216f + 0.07135481627f * x * x);
    const float e = __builtin_amdgcn_exp2f(-y2 * 1.4426950408889634f);
    return x * __builtin_amdgcn_rcpf(1.0f + e);
}
__device__ __forceinline__ int crow(int r, int hi) { return (r & 3) + 8 * (r >> 2) + 4 * hi; }

struct Args { const float* in[16]; float* out; unsigned char* ws; int ph_lo, ph_hi; };
typedef const __attribute__((address_space(4))) Args CArgs;

#define RLX_AGENT __ATOMIC_RELAXED, __HIP_MEMORY_SCOPE_AGENT
#define XB_TMO      128
#define XB_XCNT(j)  (256  + 64 * (j))
#define XB_XSUB(j)  (1280 + 64 * (j))
#define XB_XGEN(j)  (2304 + 64 * (j))
#define XB_TOP      3328
#define XB_TOPGEN   3392
#define XCD_BAR_WORDS 3456
#define XB_SPIN_CAP (1u << 18)

__device__ __forceinline__ unsigned xb_ld(unsigned* p)              { return __hip_atomic_load(p, __ATOMIC_RELAXED, __HIP_MEMORY_SCOPE_AGENT); }
__device__ __forceinline__ unsigned xb_add(unsigned* p, unsigned v) { return __hip_atomic_fetch_add(p, v, __ATOMIC_RELAXED, __HIP_MEMORY_SCOPE_AGENT); }
__device__ __forceinline__ unsigned xb_xcc_id() { return (unsigned)__builtin_amdgcn_s_getreg((3 << 11) | 20) & 0xFu; }
#define XB_SPIN(cond, bar) do { unsigned _sp = 0; while (cond) { __builtin_amdgcn_s_sleep(1); \
    if ((++_sp & 255u) == 0u) { if (xb_ld(&(bar)[XB_TMO])) break; if (_sp > XB_SPIN_CAP) { atomicAdd(&(bar)[XB_TMO], 1u); break; } } } } while (0)

struct XcdBarrier {
    unsigned* bar; unsigned x;
    volatile LAS unsigned* st;
};

__device__ __forceinline__ XcdBarrier xcd_barrier_post(unsigned* bar, volatile LAS unsigned* st) {
    XcdBarrier b; b.bar = bar; b.x = xb_xcc_id(); b.st = st;
    if (threadIdx.x == 0) (void)xb_add(&bar[XB_XCNT(b.x)], 1u);
    return b;
}
__device__ __forceinline__ void xcd_barrier_complete(unsigned* bar, unsigned x, unsigned& nloc, unsigned& nx) {
    const unsigned G = gridDim.x * gridDim.y * gridDim.z;
    unsigned sum, cnt, mine, sp = 0u;
    for (;;) {
        sum = 0u; cnt = 0u; mine = 0u;
#pragma unroll
        for (unsigned j = 0; j < 16; ++j) { const unsigned c = xb_ld(&bar[XB_XCNT(j)]); sum += c; cnt += (c > 0u) ? 1u : 0u; mine = (j == x) ? c : mine; }
        if (sum == G) break;
        __builtin_amdgcn_s_sleep(1);
        if ((++sp & 255u) == 0u) { if (xb_ld(&bar[XB_TMO])) break; if (sp > XB_SPIN_CAP) { atomicAdd(&bar[XB_TMO], 1u); break; } }
    }
    nloc = mine > 0u ? mine : 1u; nx = cnt > 0u ? cnt : 1u;
}

__device__ __forceinline__ void xcd_barrier(const XcdBarrier& b) {
    asm volatile("s_waitcnt vmcnt(0)" ::: "memory");
    __syncthreads();
    if (threadIdx.x == 0) {
        unsigned* bar = b.bar;
        __builtin_amdgcn_s_waitcnt(0);
        unsigned nloc = b.st[0], nx = b.st[1];
        if (nloc == 0u) { xcd_barrier_complete(bar, b.x, nloc, nx); b.st[0] = nloc; b.st[1] = nx; }
        const unsigned old = xb_add(&bar[XB_XSUB(b.x)], 1u);
        const unsigned gen = old / nloc;
        if (old + 1u == (gen + 1u) * nloc) {
            __builtin_amdgcn_fence(__ATOMIC_RELEASE, "agent");
            asm volatile("s_waitcnt vmcnt(0)" ::: "memory");
            const unsigned og = xb_add(&bar[XB_TOP], 1u);
            const unsigned tg = og / nx;
            if (og + 1u == (tg + 1u) * nx) xb_add(&bar[XB_TOPGEN], 1u);
            else XB_SPIN(xb_ld(&bar[XB_TOPGEN]) == tg, bar);
            __builtin_amdgcn_fence(__ATOMIC_ACQUIRE, "agent");
            xb_add(&bar[XB_XGEN(b.x)], 1u);
            asm volatile("s_waitcnt vmcnt(0)" ::: "memory");
        } else {
            XB_SPIN(xb_ld(&bar[XB_XGEN(b.x)]) == gen, bar);
            __builtin_amdgcn_fence(__ATOMIC_ACQUIRE, "agent");
            asm volatile("s_waitcnt vmcnt(0)" ::: "memory");
        }
    }
    __syncthreads();
}

__device__ __forceinline__ void p0_transpose_item(const float* W, int K, int N, bf16* WT, LAS float* scr, int item, int lane) {
    const int nblk = N / 32, kb = item / nblk, nb = item % nblk, k0 = 64 * kb, n0 = 32 * nb;
#pragma unroll 8
    for (int i = 0; i < 32; ++i) { const int kk = 2 * i + (lane >> 5); scr[kk * 33 + (lane & 31)] = W[(size_t)(k0 + kk) * N + n0 + (lane & 31)]; }
    asm volatile("s_waitcnt lgkmcnt(0)" ::: "memory");
    const int c = lane & 7;
#pragma unroll
    for (int j = 0; j < 4; ++j) { const int n = (lane >> 3) + 8 * j; const LAS float* s = scr + (8 * c) * 33 + n;
        u32x4 o; o.x = pk_bf16(s[0 * 33], s[1 * 33]); o.y = pk_bf16(s[2 * 33], s[3 * 33]); o.z = pk_bf16(s[4 * 33], s[5 * 33]); o.w = pk_bf16(s[6 * 33], s[7 * 33]);
        *(u32x4*)(WT + (size_t)(n0 + n) * K + k0 + 8 * c) = o; }
    asm volatile("s_waitcnt lgkmcnt(0)" ::: "memory");
}
__device__ __forceinline__ void phase_p0a(CArgs* ap, LAS unsigned char* lds, int tid, int wave, int lane) {
    LAS float* cact = (LAS float*)lds;
    const float* c = ap->in[1];
    for (int i = tid; i < NB * DM; i += NTHR) { const float v = c[i]; cact[i] = v / (1.0f + __expf(-v)); }
    __syncthreads();
    const int gw = blockIdx.x * NWAVES + wave, NGW = gridDim.x * NWAVES;
    float* MODP = (float*)(ap->ws + WS_R);
    const float* ada_w = ap->in[2];
    for (int it = gw; it < 1536; it += NGW) {
        const int l = it / 768, r = it % 768, kc = r / 24, cgp = r % 24;
        const float* W = ada_w + (size_t)l * DM * NMOD + (size_t)(kc * 32) * NMOD + cgp * 256 + lane * 4;
        f32x4 acc[8];
#pragma unroll
        for (int b = 0; b < 8; ++b) acc[b] = (f32x4){0.f, 0.f, 0.f, 0.f};
#pragma unroll 8
        for (int k = 0; k < 32; ++k) { const f32x4 w = *(const f32x4*)(W + (size_t)k * NMOD);
#pragma unroll
            for (int b = 0; b < 8; ++b) { const float cv = cact[b * DM + kc * 32 + k]; acc[b] += w * cv; } }
#pragma unroll
        for (int b = 0; b < 8; ++b) *(f32x4*)(MODP + ((size_t)((l * 32 + kc) * 8 + b)) * NMOD + cgp * 256 + lane * 4) = acc[b];
    }
    LAS float* scr = (LAS float*)(lds + 32768 + wave * 8704);
    constexpr int I_IN = (DM / 64) * (PW / 32), I_OUT = (DM / 64) * (DM / 32), I_1 = (DM / 64) * (DFF / 32), I_2 = (DFF / 64) * (DM / 32);
    constexpr int I_LAYER = I_IN + I_OUT + I_1 + I_2;
    const int gws = (gw + NGW - (1536 % NGW)) % NGW;
    for (int it = gws; it < DEPTH * I_LAYER; it += NGW) {
        const int l = it / I_LAYER; int r = it % I_LAYER;
        unsigned char* wt = ap->ws + WS_WT + (size_t)l * WT_LAYER;
        if (r < I_IN) { p0_transpose_item(ap->in[6] + (size_t)l * DM * PW, DM, PW, (bf16*)(wt + WT_IN), scr, r, lane); continue; } r -= I_IN;
        if (r < I_OUT) { p0_transpose_item(ap->in[12] + (size_t)l * DM * DM, DM, DM, (bf16*)(wt + WT_OUT), scr, r, lane); continue; } r -= I_OUT;
        if (r < I_1) { p0_transpose_item(ap->in[13] + (size_t)l * DM * DFF, DM, DFF, (bf16*)(wt + WT_1), scr, r, lane); continue; } r -= I_1;
        p0_transpose_item(ap->in[14] + (size_t)l * DFF * DM, DFF, DM, (bf16*)(wt + WT_2), scr, r, lane);
    }
}
__device__ __forceinline__ void phase_p0b(CArgs* ap, int tid) {
    const float* MODP = (const float*)(ap->ws + WS_R); float* MOD = (float*)(ap->ws + WS_MOD); const float* ada_b = ap->in[3];
    for (int idx = blockIdx.x * NTHR + tid; idx < DEPTH * NB * NMOD; idx += gridDim.x * NTHR) {
        const int l = idx / (NB * NMOD), rem = idx % (NB * NMOD), b = rem / NMOD, col = rem % NMOD;
        float s = ada_b[l * NMOD + col];
#pragma unroll 8
        for (int kc = 0; kc < 32; ++kc) s += MODP[((size_t)((l * 32 + kc) * 8 + b)) * NMOD + col];
        MOD[idx] = s;
    }
}
__device__ __forceinline__ void phase_norm_mod(const float* x, bf16* h, const float* g, const float* shift, const float* scale, int wave, int lane) {
    const int gw = blockIdx.x * NWAVES + wave, NGW = gridDim.x * NWAVES;
    for (int m = gw; m < MTOK; m += NGW) {
        const int b = m >> 11;
        const f32x4* xr = (const f32x4*)(x + (size_t)m * DM) + lane;
        f32x4 v[4]; float s = 0.f;
#pragma unroll
        for (int j = 0; j < 4; ++j) { v[j] = xr[64 * j]; s += (v[j].x * v[j].x + v[j].y * v[j].y) + (v[j].z * v[j].z + v[j].w * v[j].w); }
        const float rstd = 1.0f / sqrtf(wave_sum(s) * (1.0f / DM) + EPS);
        unsigned long long* o8 = (unsigned long long*)(h + (size_t)m * DM) + lane;
#pragma unroll
        for (int j = 0; j < 4; ++j) {
            const f32x4 gg = *((const f32x4*)g + lane + 64 * j), sc = *((const f32x4*)(scale + (size_t)b * NMOD) + lane + 64 * j), sh = *((const f32x4*)(shift + (size_t)b * NMOD) + lane + 64 * j);
            const f32x4 y = (v[j] * rstd) * gg * (sc + 1.0f) + sh;
            o8[64 * j] = (unsigned long long)pk_bf16(y.x, y.y) | ((unsigned long long)pk_bf16(y.z, y.w) << 32);
        }
    }
}
__device__ __forceinline__ void phase_final_norm(float* x, const float* g, int wave, int lane) {
    const int gw = blockIdx.x * NWAVES + wave, NGW = gridDim.x * NWAVES;
    for (int m = gw; m < MTOK; m += NGW) {
        f32x4* xr = (f32x4*)(x + (size_t)m * DM) + lane;
        f32x4 v[4]; float s = 0.f;
#pragma unroll
        for (int j = 0; j < 4; ++j) { v[j] = xr[64 * j]; s += (v[j].x * v[j].x + v[j].y * v[j].y) + (v[j].z * v[j].z + v[j].w * v[j].w); }
        const float rstd = 1.0f / sqrtf(wave_sum(s) * (1.0f / DM) + EPS);
#pragma unroll
        for (int j = 0; j < 4; ++j) xr[64 * j] = (v[j] * rstd) * *((const f32x4*)g + lane + 64 * j);
    }
}
constexpr int WLDS = 17920;
constexpr int VNT_STRIDE = 136, VT_STRIDE = 36;
constexpr float LOG2E = 1.4426950408889634f;
__device__ __forceinline__ void attn_unit(const bf16* PROJ, bf16* MIX, int b, int h, int qt, LAS unsigned char* wl, int lane) {
    const int q32 = lane & 31, hi = lane >> 5;
    const size_t rowbase = (size_t)b * SEQ;
    const int tq = qt * 32 + q32;
    LAS unsigned short* Vt = (LAS unsigned short*)wl;
    bf16x8 qf[4];
    { const bf16* Qp = PROJ + (rowbase + tq) * PW + h * 64 + hi * 8;
#pragma unroll
      for (int d0 = 0; d0 < 4; ++d0) qf[d0] = *(const bf16x8*)(Qp + d0 * 16); }
    f32x16 o0 = {}, o1 = {};
    float carry = 0.f;
    const bf16* Kp = PROJ + (rowbase + q32) * PW + 512 + h * 64 + hi * 8;
    const bf16* Vp = PROJ + (rowbase + (lane >> 3)) * PW + 1024 + h * 64 + (lane & 7) * 8;
#define ATT_LOAD(KF, VV, kt_) do { const int k0_ = (kt_) * 32; \
        _Pragma("unroll") for (int d0 = 0; d0 < 4; ++d0) KF[d0] = *(const bf16x8*)(Kp + (size_t)k0_ * PW + d0 * 16); \
        _Pragma("unroll") for (int i = 0; i < 4; ++i) VV[i] = *(const bf16x8*)(Vp + (size_t)(k0_ + 8 * i) * PW); } while (0)
    auto tile = [&](const bf16x8 (&kf)[4], const bf16x8 (&vv)[4], int kt) __attribute__((always_inline)) -> bool {
        const int k0 = kt * 32;
#pragma unroll
        for (int i = 0; i < 4; ++i) { const int key = (lane >> 3) + 8 * i, dc = lane & 7;
#pragma unroll
            for (int j = 0; j < 8; ++j) Vt[(dc * 8 + j) * VT_STRIDE + key] = (unsigned short)vv[i][j]; }
        f32x16 S = {};
#pragma unroll
        for (int d0 = 0; d0 < 4; ++d0) S = __builtin_amdgcn_mfma_f32_32x32x16_bf16(kf[d0], qf[d0], S, 0, 0, 0);
        float z2[16], sp[16];
#pragma unroll
        for (int r = 0; r < 16; ++r) {
            const int key = k0 + crow(r, hi); const bool valid = key < tq;
            const float z = S[r] * (0.125f * LOG2E); z2[r] = z;
            const float e = __builtin_amdgcn_exp2f(-fabsf(z));
            const float s = fmaxf(z, 0.f) + __builtin_amdgcn_logf(1.0f + e);
            sp[r] = valid ? s : 0.f;
        }
        float T[4], U[4];
#pragma unroll
        for (int g = 0; g < 4; ++g) { sp[4 * g + 2] += sp[4 * g + 3]; sp[4 * g + 1] += sp[4 * g + 2]; sp[4 * g + 0] += sp[4 * g + 1]; T[g] = sp[4 * g]; }
#pragma unroll
        for (int g = 0; g < 4; ++g) U[g] = __shfl_xor(T[g], 32);
        float R = carry, off[4];
#pragma unroll
        for (int g = 3; g >= 0; --g) { off[g] = R + (hi == 0 ? U[g] : 0.f); R += T[g] + U[g]; }
        carry = R;
        unsigned pw[8];
#pragma unroll
        for (int r = 0; r < 16; r += 2) {
            const int key = k0 + crow(r, hi);
            float w0 = __builtin_amdgcn_exp2f(z2[r] - (sp[r] + off[r >> 2])), w1 = __builtin_amdgcn_exp2f(z2[r + 1] - (sp[r + 1] + off[r >> 2]));
            w0 = (key < tq) ? w0 : 0.f; w1 = (key + 1 < tq) ? w1 : 0.f;
            pw[r >> 1] = pk_bf16(w0, w1);
        }
        const bf16x8 pb0 = __builtin_bit_cast(bf16x8, (u32x4){pw[0], pw[1], pw[2], pw[3]}), pb1 = __builtin_bit_cast(bf16x8, (u32x4){pw[4], pw[5], pw[6], pw[7]});
        asm volatile("s_waitcnt lgkmcnt(0)" ::: "memory"); __builtin_amdgcn_wave_barrier();
#pragma unroll
        for (int dblk = 0; dblk < 2; ++dblk) {
            const LAS unsigned short* vp = Vt + (dblk * 32 + q32) * VT_STRIDE + 4 * hi;
            const u32x2 a00 = *(const LAS u32x2*)(vp), a01 = *(const LAS u32x2*)(vp + 8), a10 = *(const LAS u32x2*)(vp + 16), a11 = *(const LAS u32x2*)(vp + 24);
            const bf16x8 va0 = __builtin_bit_cast(bf16x8, (u32x4){a00.x, a00.y, a01.x, a01.y}), va1 = __builtin_bit_cast(bf16x8, (u32x4){a10.x, a10.y, a11.x, a11.y});
            if (dblk == 0) { o0 = __builtin_amdgcn_mfma_f32_32x32x16_bf16(va0, pb0, o0, 0, 0, 0); o0 = __builtin_amdgcn_mfma_f32_32x32x16_bf16(va1, pb1, o0, 0, 0, 0); }
            else           { o1 = __builtin_amdgcn_mfma_f32_32x32x16_bf16(va0, pb0, o1, 0, 0, 0); o1 = __builtin_amdgcn_mfma_f32_32x32x16_bf16(va1, pb1, o1, 0, 0, 0); }
        }
        asm volatile("s_waitcnt lgkmcnt(0)" ::: "memory"); __builtin_amdgcn_wave_barrier();
        return __all(carry > 152.0f) != 0;
    };
    bf16x8 kA[4], vA[4], kB[4], vB[4];
    ATT_LOAD(kA, vA, qt);
    for (int kt = qt;;) {
        ATT_LOAD(kB, vB, (kt > 0 ? kt - 1 : 0));
        if (tile(kA, vA, kt)) break;
        if (--kt < 0) break;
        ATT_LOAD(kA, vA, (kt > 0 ? kt - 1 : 0));
        if (tile(kB, vB, kt)) break;
        if (--kt < 0) break;
    }
#undef ATT_LOAD
    bf16* Op = MIX + (rowbase + tq) * DM + h * 64 + 4 * hi;
#pragma unroll
    for (int g = 0; g < 4; ++g) {
        *(u32x2*)(Op + 8 * g) = (u32x2){pk_bf16(o0[4 * g], o0[4 * g + 1]), pk_bf16(o0[4 * g + 2], o0[4 * g + 3])};
        *(u32x2*)(Op + 32 + 8 * g) = (u32x2){pk_bf16(o1[4 * g], o1[4 * g + 1]), pk_bf16(o1[4 * g + 2], o1[4 * g + 3])};
    }
}
__device__ __forceinline__ void gate_block_unit(const bf16* PROJ, bf16* MIX, const float* gn, const float* sw, const float* sb, int b, int win, int h, LAS unsigned char* lds, int wave, int lane) {
    const size_t r0 = (size_t)b * SEQ + (size_t)win * 128;
    LAS unsigned short* Vnt = (LAS unsigned short*)lds;
    {
        const int row = wave * 16 + (lane >> 2), q = lane & 3;
        const bf16* vp = PROJ + (r0 + row) * PW + 2560 + q * 16;
        u32x4 v[8];
#pragma unroll
        for (int hh = 0; hh < 4; ++hh) { v[2 * hh] = *(const u32x4*)(vp + hh * 64); v[2 * hh + 1] = *(const u32x4*)(vp + hh * 64 + 8); }
        const u32x4 o0 = *(const u32x4*)(vp + h * 64), o1 = *(const u32x4*)(vp + h * 64 + 8);
        f32x4 gg[4];
#pragma unroll
        for (int j = 0; j < 4; ++j) gg[j] = *(const f32x4*)(gn + h * 64 + q * 16 + 4 * j);
        float ss = 0.f;
#pragma unroll
        for (int i = 0; i < 8; ++i)
#pragma unroll
            for (int e = 0; e < 4; ++e) { const float g0 = gelu_tanh(bf_lo(v[i][e])), g1 = gelu_tanh(bf_hi(v[i][e])); ss += g0 * g0 + g1 * g1; }
        ss += __shfl_xor(ss, 1); ss += __shfl_xor(ss, 2);
        const float rs = 1.0f / sqrtf(ss * (1.0f / 256.0f) + EPS);
#pragma unroll
        for (int e = 0; e < 4; ++e) {
            const float y0 = gelu_tanh(bf_lo(o0[e])) * rs * gg[e >> 1][(2 * e) & 3], y1 = gelu_tanh(bf_hi(o0[e])) * rs * gg[e >> 1][(2 * e + 1) & 3];
            const float y2 = gelu_tanh(bf_lo(o1[e])) * rs * gg[2 + (e >> 1)][(2 * e) & 3], y3 = gelu_tanh(bf_hi(o1[e])) * rs * gg[2 + (e >> 1)][(2 * e + 1) & 3];
            const unsigned pa = pk_bf16(y0, y1), pb = pk_bf16(y2, y3);
            const int d = q * 16 + 2 * e;
            Vnt[d * VNT_STRIDE + row] = (unsigned short)(pa & 0xffffu); Vnt[(d + 1) * VNT_STRIDE + row] = (unsigned short)(pa >> 16);
            Vnt[(d + 8) * VNT_STRIDE + row] = (unsigned short)(pb & 0xffffu); Vnt[(d + 9) * VNT_STRIDE + row] = (unsigned short)(pb >> 16);
        }
    }
    __syncthreads();
    {
        const int tb = wave >> 1, dblk = wave & 1, q32 = lane & 31, hi = lane >> 5, t = tb * 32 + q32;
        const float* Wr = sw + ((size_t)h * 128 + t) * 128 + 8 * hi;
        const LAS unsigned short* Ar = Vnt + (dblk * 32 + q32) * VNT_STRIDE + 8 * hi;
        const bf16* up = PROJ + (r0 + t) * PW + 2304 + h * 64 + dblk * 32 + 4 * hi;
        u32x2 uu[4];
#pragma unroll
        for (int g = 0; g < 4; ++g) uu[g] = *(const u32x2*)(up + 8 * g);
        const float bias = sb[h * 128 + t];
        f32x16 c = {};
        f32x4 w[8];
#pragma unroll
        for (int ks = 0; ks < 4; ++ks) { w[2 * ks] = *(const f32x4*)(Wr + ks * 16); w[2 * ks + 1] = *(const f32x4*)(Wr + ks * 16 + 4); }
#pragma unroll
        for (int ks = 0; ks < 4; ++ks) {
            const bf16x8 wb = __builtin_bit_cast(bf16x8, (u32x4){pk_bf16(w[2 * ks].x, w[2 * ks].y), pk_bf16(w[2 * ks].z, w[2 * ks].w), pk_bf16(w[2 * ks + 1].x, w[2 * ks + 1].y), pk_bf16(w[2 * ks + 1].z, w[2 * ks + 1].w)});
            c = __builtin_amdgcn_mfma_f32_32x32x16_bf16(*(const LAS bf16x8*)(Ar + ks * 16), wb, c, 0, 0, 0);
        }
        if (tb >= 2) {
#pragma unroll
            for (int ks = 0; ks < 4; ++ks) { w[2 * ks] = *(const f32x4*)(Wr + 64 + ks * 16); w[2 * ks + 1] = *(const f32x4*)(Wr + 64 + ks * 16 + 4); }
#pragma unroll
            for (int ks = 0; ks < 4; ++ks) {
                const bf16x8 wb = __builtin_bit_cast(bf16x8, (u32x4){pk_bf16(w[2 * ks].x, w[2 * ks].y), pk_bf16(w[2 * ks].z, w[2 * ks].w), pk_bf16(w[2 * ks + 1].x, w[2 * ks + 1].y), pk_bf16(w[2 * ks + 1].z, w[2 * ks + 1].w)});
                c = __builtin_amdgcn_mfma_f32_32x32x16_bf16(*(const LAS bf16x8*)(Ar + 64 + ks * 16), wb, c, 0, 0, 0);
            }
        }
        bf16* op = MIX + (r0 + t) * DM + 768 + h * 64 + dblk * 32 + 4 * hi;
#pragma unroll
        for (int g = 0; g < 4; ++g) {
            const float a = gelu_tanh(bf_lo(uu[g].x)) * (c[4 * g] + bias), bb = gelu_tanh(bf_hi(uu[g].x)) * (c[4 * g + 1] + bias), cc = gelu_tanh(bf_lo(uu[g].y)) * (c[4 * g + 2] + bias), dd = gelu_tanh(bf_hi(uu[g].y)) * (c[4 * g + 3] + bias);
            *(u32x2*)(op + 8 * g) = (u32x2){pk_bf16(a, bb), pk_bf16(cc, dd)};
        }
    }
    __syncthreads();
}
__device__ __forceinline__ void conv_unit(const bf16* PROJ, bf16* MIX, const float* cw, const float* cb, int unit, int lane) {
    const size_t R0 = (size_t)unit * 8; const int ch = lane * 4;
    const f32x4 w0 = *(const f32x4*)(cw + ch), w1 = *(const f32x4*)(cw + 256 + ch), w2 = *(const f32x4*)(cw + 512 + ch), bb = *(const f32x4*)(cb + ch);
    const bool first = (R0 & (SEQ - 1)) == 0;
    const bf16* base = PROJ + (first ? R0 : R0 - 2) * PW + ch;
    u32x2 rc[10], rh[10], rb[8];
#pragma unroll
    for (int i = 0; i < 10; ++i) { rc[i] = *(const u32x2*)(base + (size_t)i * PW + 1792); rh[i] = *(const u32x2*)(base + (size_t)i * PW + 2048); }
    const bf16* bgp = PROJ + R0 * PW + 1536 + ch;
#pragma unroll
    for (int i = 0; i < 8; ++i) rb[i] = *(const u32x2*)(bgp + (size_t)i * PW);
    auto cv = [](u32x2 v) { return (f32x4){bf_lo(v.x), bf_hi(v.x), bf_lo(v.y), bf_hi(v.y)}; };
    f32x4 u[10];
#pragma unroll
    for (int i = 0; i < 10; ++i) u[i] = cv(rc[i]) * cv(rh[i]);
    if (first) {
#pragma unroll
        for (int i = 9; i >= 2; --i) u[i] = u[i - 2];
        u[0] = (f32x4){0.f, 0.f, 0.f, 0.f}; u[1] = u[0];
    }
#pragma unroll
    for (int i = 0; i < 8; ++i) {
        const f32x4 y = cv(rb[i]) * (w0 * u[i] + w1 * u[i + 1] + w2 * u[i + 2] + bb);
        *(u32x2*)(MIX + (R0 + i) * DM + 512 + ch) = (u32x2){pk_bf16(y.x, y.y), pk_bf16(y.z, y.w)};
    }
}
__device__ __forceinline__ void phase_mixers(CArgs* ap, int l, LAS unsigned char* lds, int wave, int lane) {
    const bf16* PROJ = (const bf16*)(ap->ws + WS_R); bf16* MIX = (bf16*)(ap->ws + WS_MIX);
    constexpr int NG = NB * 16 * 4, NA = NB * 8 * 64, NC = MTOK / 8;
    for (int it = blockIdx.x; it < NG; it += gridDim.x) { const int b = it >> 6, win = (it >> 2) & 15, h = it & 3;
        gate_block_unit(PROJ, MIX, ap->in[9] + l * 256, ap->in[10] + (size_t)l * 4 * 128 * 128, ap->in[11] + l * 4 * 128, b, win, h, lds, wave, lane); }
    LAS unsigned char* wl = lds + wave * 4608;
    const int gw = blockIdx.x * NWAVES + wave, NGW = gridDim.x * NWAVES;
#ifdef PROBE_ATTN2
    for (int it = gw; it < NA; it += NGW) { const int qt = 63 - (it >> 6), bh = it & 63; attn_unit(PROJ, MIX, bh >> 3, bh & 7, qt, wl, lane); }
#endif
#ifdef PROBE_CONV2
    for (int it = gw; it < NC; it += NGW) conv_unit(PROJ, MIX, ap->in[7] + l * 3 * 256, ap->in[8] + l * 256, it, lane);
#endif
    for (int it = gw; it < NA + NC; it += NGW) {
        if (it < NA) { const int qt = 63 - (it >> 6), bh = it & 63; attn_unit(PROJ, MIX, bh >> 3, bh & 7, qt, wl, lane); }
        else { conv_unit(PROJ, MIX, ap->in[7] + l * 3 * 256, ap->in[8] + l * 256, it - NA, lane); }
    }
}

__global__ void __launch_bounds__(NTHR, 2) trunk_fwd(Args a_unused) {
    extern __shared__ __attribute__((aligned(16))) unsigned char lds_raw[];
    LAS unsigned char* lds = (LAS unsigned char*)lds_raw;
    cg::grid_group grid = cg::this_grid();
    CArgs* kp = (CArgs*)__builtin_amdgcn_kernarg_segment_ptr();
    if (threadIdx.x < 16) ((LAS unsigned*)(lds + MISC_OFF))[threadIdx.x] = 0u;
    __syncthreads();
    const XcdBarrier bar = xcd_barrier_post((unsigned*)(kp->ws + WS_CTL), (volatile LAS unsigned*)(lds + MISC_OFF));
    const int lo = kp->ph_lo, hi = kp->ph_hi;
#define KA CArgs* ap = kp; asm volatile("" : "+s"(ap));
#define TIDS int tid = threadIdx.x; asm volatile("" : "+v"(tid)); const int lane = tid & 63, wave = __builtin_amdgcn_readfirstlane(tid >> 6); (void)lane; (void)wave;
#define IN(k) (lo <= (k) && (k) < hi)
#define SEAM(k) do { if ((k) + 1 < hi) { if ((k) == 0) grid.sync(); else xcd_barrier(bar); } } while (0)
#ifndef REP_MASK
#define REP_MASK 0u
#endif
#define REPB(k) for (int rep_ = 0, nrep_ = (int)((REP_MASK >> (k)) & 1u); rep_ <= nrep_; ++rep_) { if (rep_) xcd_barrier(bar);
#define REPE }
    if (IN(0)) { REPB(0) TIDS; KA; phase_p0a(ap, lds, tid, wave, lane); REPE SEAM(0); }
#ifdef PROBE_SYNC10
    for (int i_ = 0; i_ < 10; ++i_) xcd_barrier(bar);
#endif
    if (IN(1)) { REPB(1) TIDS; KA; phase_p0b(ap, tid); REPE SEAM(1); }
#pragma unroll 1
    for (int l0 = 0; l0 < DEPTH; ++l0) {
        const int p = 2 + 7 * l0;
#define LPTRS KA; int l = l0; asm volatile("" : "+s"(l)); const float* mod = (const float*)(ap->ws + WS_MOD) + (size_t)l * NB * NMOD; const unsigned char* wt = ap->ws + WS_WT + (size_t)l * WT_LAYER; const float* xin = (l == 0) ? ap->in[0] : ap->out; float* X = ap->out; \
        bf16* H = (bf16*)(ap->ws + WS_H); bf16* PROJ = (bf16*)(ap->ws + WS_R); bf16* MIX = (bf16*)(ap->ws + WS_MIX); bf16* A1 = (bf16*)(ap->ws + WS_R); (void)mod; (void)wt; (void)xin; (void)X; (void)H; (void)PROJ; (void)MIX; (void)A1;
        if (IN(p + 0)) { REPB(p + 0) TIDS; LPTRS; phase_norm_mod(xin, H, ap->in[4] + l * DM, mod + 0 * DM, mod + 1 * DM, wave, lane); REPE SEAM(p + 0); }
        if (IN(p + 1)) { REPB(p + 1) __syncthreads(); LPTRS;
            pg8::Gemm g{H, (const bf16*)(wt + WT_IN), MTOK, PW, DM}; pg8::StaticOrder S; S.init(MTOK, PW, gridDim.x, blockIdx.x);
            pg8::EpiBf16<0> E{PROJ, PW};
            pg8::gemm_phase<pg8::EpiBf16<0>, pg8::StaticOrder, true, true>(lds, g, S, E); REPE SEAM(p + 1); }
        if (IN(p + 2)) { REPB(p + 2) __syncthreads(); TIDS; LPTRS; phase_mixers(ap, l, lds, wave, lane); REPE SEAM(p + 2); }
        if (IN(p + 3)) { REPB(p + 3) __syncthreads(); LPTRS;
            pg8::Gemm g{MIX, (const bf16*)(wt + WT_OUT), MTOK, DM, DM}; pg8::StaticOrder S; S.init(MTOK, DM, gridDim.x, blockIdx.x);
            pg8::EpiResGate E{xin, X, mod + 2 * DM, NMOD};
            pg8::gemm_phase<pg8::EpiResGate, pg8::StaticOrder, true, true>(lds, g, S, E); REPE SEAM(p + 3); }
        if (IN(p + 4)) { REPB(p + 4) TIDS; LPTRS; phase_norm_mod(X, H, ap->in[5] + l * DM, mod + 3 * DM, mod + 4 * DM, wave, lane); REPE SEAM(p + 4); }
        if (IN(p + 5)) { REPB(p + 5) __syncthreads(); LPTRS;
            pg8::Gemm g{H, (const bf16*)(wt + WT_1), MTOK, DFF, DM}; pg8::StaticOrder S; S.init(MTOK, DFF, gridDim.x, blockIdx.x);
            pg8::EpiBf16<2> E{A1, DFF};
            pg8::gemm_phase<pg8::EpiBf16<2>, pg8::StaticOrder, true, true>(lds, g, S, E); REPE SEAM(p + 5); }
#ifdef PROBE_W2
        if (IN(p + 6)) { __syncthreads(); LPTRS;
            pg8::Gemm g{A1, (const bf16*)(wt + WT_2), MTOK, DM, DFF}; pg8::StaticOrder S; S.init(MTOK, DM, gridDim.x, blockIdx.x);
            pg8::EpiNull E{X};
            pg8::gemm_phase<pg8::EpiNull, pg8::StaticOrder, true, true>(lds, g, S, E); xcd_barrier(bar); }
#endif
        if (IN(p + 6)) { REPB(p + 6) __syncthreads(); LPTRS;
            pg8::Gemm g{A1, (const bf16*)(wt + WT_2), MTOK, DM, DFF}; pg8::StaticOrder S; S.init(MTOK, DM, gridDim.x, blockIdx.x);
            pg8::EpiResGate E{X, X, mod + 5 * DM, NMOD};
            pg8::gemm_phase<pg8::EpiResGate, pg8::StaticOrder, true, true>(lds, g, S, E); REPE SEAM(p + 6); }
    }
    if (IN(16)) { TIDS; KA; phase_final_norm(ap->out, ap->in[15], wave, lane); }
#undef IN
#undef SEAM
}

#ifndef MK_N_LAUNCHES
#define MK_N_LAUNCHES 1
#endif
extern "C" void kernel_launch(void* const* d_in, const int* in_sizes, int n_in, void* d_out, int out_size, void* d_ws, size_t ws_size, hipStream_t stream) {
    static int grid = 0;
    if (grid == 0) {
        if (n_in != 16 || out_size != MTOK * DM || ws_size < WS_END) { fprintf(stderr, "kernel_launch: unexpected shapes (n_in %d out %d ws %zu)\n", n_in, out_size, ws_size); grid = -1; return; }
        int dev = 0, cus = 0, per_cu = 0;
        hipGetDevice(&dev); hipDeviceGetAttribute(&cus, hipDeviceAttributeMultiprocessorCount, dev);
        hipFuncSetAttribute((const void*)trunk_fwd, hipFuncAttributeMaxDynamicSharedMemorySize, LDS_BYTES);
        if (hipOccupancyMaxActiveBlocksPerMultiprocessor(&per_cu, (const void*)trunk_fwd, NTHR, LDS_BYTES) != hipSuccess || per_cu < 1) { fprintf(stderr, "kernel_launch: occupancy query failed (%d)\n", per_cu); (void)hipGetLastError(); per_cu = 1; }
        grid = cus * (per_cu > 1 ? 1 : per_cu);
    }
    if (grid < 0) return;
    if (hipMemsetAsync((char*)d_ws + WS_CTL, 0, CTL_BYTES, stream) != hipSuccess) { fprintf(stderr, "kernel_launch: memset of the barrier words failed\n"); return; }
    Args a{};
    for (int i = 0; i < 16; ++i) a.in[i] = (const float*)d_in[i];
    a.out = (float*)d_out; a.ws = (unsigned char*)d_ws;
#if MK_N_LAUNCHES == 1
    a.ph_lo = 0; a.ph_hi = NPHASE;
    { void* args[] = {&a}; hipError_t e = hipLaunchCooperativeKernel((const void*)trunk_fwd, dim3(grid), dim3(NTHR), args, LDS_BYTES, stream);
      if (e != hipSuccess) fprintf(stderr, "cooperative launch failed: %s (grid %d)\n", hipGetErrorString(e), grid); }
#else
    for (int p = 0; p < NPHASE; ++p) { a.ph_lo = p; a.ph_hi = p + 1; void* args[] = {&a};
        hipError_t e = hipLaunchCooperativeKernel((const void*)trunk_fwd, dim3(grid), dim3(NTHR), args, LDS_BYTES, stream);
        if (e != hipSuccess) { fprintf(stderr, "launch %d failed: %s\n", p, hipGetErrorString(e)); break; } }
#endif
}
```
